# Optimizing an MI355X kernel written in HIP

```python
import math
import jax, jax.numpy as jnp
from jax import lax
import numpy as np

D_MODEL = 1024
BATCH = 4
SEQ = 8192
DEPTH = 2

N_EVEN = (DEPTH + 1) // 2
N_ODD = DEPTH // 2
LRU_WIDTH = D_MODEL
LRU_BLOCKS = 8
LRU_BLOCK = LRU_WIDTH // LRU_BLOCKS
LRU_C = 8.0
CONV_WIDTH = 4
SB_HEADS = 8
SB_HEAD_DIM = 128
SB_WIDTH = SB_HEADS * SB_HEAD_DIM
C_HEADS = 16
C_KV_HEADS = 2
C_GROUP = C_HEADS // C_KV_HEADS
C_HEAD_DIM = 64
C_WIDTH = C_HEADS * C_HEAD_DIM
C_KV_WIDTH = C_KV_HEADS * C_HEAD_DIM
WINDOW = 128
Q_BLOCK = 128
EVEN_IN = 2 * LRU_WIDTH + 4 * SB_WIDTH
EVEN_MIX = LRU_WIDTH + SB_WIDTH
ODD_IN = 2 * C_WIDTH + 2 * C_KV_WIDTH
DEEPNORM_ALPHA = float((2 * DEPTH) ** 0.25)
DEEPNORM_BETA = float((8 * DEPTH) ** -0.25)
LN_EPS = 1e-5

kernel_name = "hybrid_rglru_stickbreak_swa_deepnorm"


def _layer_norm(x, g, b):
    xf = x.astype(jnp.float32)
    mu = jnp.mean(xf, axis=-1, keepdims=True)
    var = jnp.mean(jnp.square(xf - mu), axis=-1, keepdims=True)
    y = (xf - mu) * lax.rsqrt(var + LN_EPS) * g.astype(jnp.float32) + b.astype(jnp.float32)
    return y.astype(x.dtype)


def _causal_dwconv(x, w, b):
    s = x.shape[1]
    xp = jnp.pad(x, ((0, 0), (CONV_WIDTH - 1, 0), (0, 0)))
    y = b
    for k in range(CONV_WIDTH):
        y = y + w[k] * xp[:, k:k + s]
    return y


def _rg_lru(x, w_a, b_a, w_x, b_x, lam):
    bsz, s, _ = x.shape
    xb = x.reshape(bsz, s, LRU_BLOCKS, LRU_BLOCK)
    r = jax.nn.sigmoid(jnp.einsum('bsnd,nde->bsne', xb, w_a).reshape(bsz, s, LRU_WIDTH) + b_a)
    i = jax.nn.sigmoid(jnp.einsum('bsnd,nde->bsne', xb, w_x).reshape(bsz, s, LRU_WIDTH) + b_x)
    log_a = LRU_C * r.astype(jnp.float32) * jax.nn.log_sigmoid(lam.astype(jnp.float32))
    a = jnp.exp(log_a)
    u = jnp.sqrt(-jnp.expm1(2.0 * log_a)) * (i * x).astype(jnp.float32)

    def combine(lhs, rhs):
        a1, b1 = lhs
        a2, b2 = rhs
        return a1 * a2, a2 * b1 + b2

    _, h = lax.associative_scan(combine, (a, u), axis=1)
    return h.astype(x.dtype)


def _stick_breaking(q, k, v):
    bsz, s, h, dh = q.shape
    nb = s // Q_BLOCK
    scale = 1.0 / math.sqrt(dh)
    qb = q.reshape(bsz, nb, Q_BLOCK, h, dh).transpose(1, 0, 2, 3, 4)
    kpos = jnp.arange(s)

    def one_block(args):
        n, qblk = args
        z = jnp.einsum('bqhd,bkhd->bhqk', qblk, k).astype(jnp.float32) * scale
        qpos = n * Q_BLOCK + jnp.arange(Q_BLOCK)
        causal = kpos[None, :] < qpos[:, None]
        log_1mb = jnp.where(causal, jax.nn.log_sigmoid(-z), 0.0)
        suffix = lax.cumsum(log_1mb, axis=3, reverse=True) - log_1mb
        w = jnp.where(causal, jnp.exp(jax.nn.log_sigmoid(z) + suffix), 0.0)
        return jnp.einsum('bhqk,bkhd->bqhd', w.astype(v.dtype), v)

    o = lax.map(one_block, (jnp.arange(nb), qb))
    return o.transpose(1, 0, 2, 3, 4).reshape(bsz, s, h, dh)


def _alibi_slopes(n_heads):
    return np.array([2.0 ** (-8.0 * (i + 1) / n_heads) for i in range(n_heads)], dtype=np.float32)


def _swa_sinks_alibi(q, k, v, sinks):
    bsz, s, _, dh = q.shape
    nb = s // Q_BLOCK
    scale = 1.0 / math.sqrt(dh)
    qb = q.reshape(bsz, nb, Q_BLOCK, C_KV_HEADS, C_GROUP, dh)
    kp = jnp.pad(k, ((0, 0), (Q_BLOCK, 0), (0, 0), (0, 0))).reshape(bsz, nb + 1, Q_BLOCK, C_KV_HEADS, dh)
    vp = jnp.pad(v, ((0, 0), (Q_BLOCK, 0), (0, 0), (0, 0))).reshape(bsz, nb + 1, Q_BLOCK, C_KV_HEADS, dh)
    kc = jnp.concatenate([kp[:, :-1], kp[:, 1:]], axis=2)
    vc = jnp.concatenate([vp[:, :-1], vp[:, 1:]], axis=2)
    sc = jnp.einsum('bnqcgd,bnkcd->bncgqk', qb, kc).astype(jnp.float32) * scale
    i = jnp.arange(Q_BLOCK)[:, None]
    j = jnp.arange(2 * Q_BLOCK)[None, :]
    dist = (i - j + Q_BLOCK).astype(jnp.float32)
    kpos = jnp.arange(nb)[:, None, None] * Q_BLOCK - Q_BLOCK + j[None]
    valid = (dist >= 0) & (dist < WINDOW) & (kpos >= 0)
    slopes = jnp.asarray(_alibi_slopes(C_HEADS)).reshape(C_KV_HEADS, C_GROUP)
    sc = sc - slopes[:, :, None, None] * dist
    sc = jnp.where(valid[None, :, None, None], sc, -jnp.inf)
    sink = sinks.astype(jnp.float32).reshape(C_KV_HEADS, C_GROUP)[:, :, None, None]
    m = jnp.maximum(jnp.max(sc, axis=-1, keepdims=True), sink)
    p = jnp.exp(sc - m)
    denom = jnp.sum(p, axis=-1, keepdims=True) + jnp.exp(sink - m)
    p = (p / denom).astype(v.dtype)
    o = jnp.einsum('bncgqk,bnkcd->bnqcgd', p, vc)
    return o.reshape(bsz, s, C_HEADS, dh)


def _even_layer(x, w_in, conv_w, conv_b, w_gate_a, b_gate_a, w_gate_x, b_gate_x, lru_lambda, w_out):
    bsz, s, _ = x.shape
    hproj = jnp.einsum('bsd,de->bse', x, w_in)
    splits = np.cumsum([LRU_WIDTH, LRU_WIDTH, SB_WIDTH, SB_WIDTH, SB_WIDTH])
    a_x, a_g, b_q, b_k, b_v, b_g = jnp.split(hproj, splits, axis=-1)
    a_h = _rg_lru(_causal_dwconv(a_x, conv_w, conv_b), w_gate_a, b_gate_a, w_gate_x, b_gate_x, lru_lambda)
    y_a = a_h * jax.nn.silu(a_g)
    shp = (bsz, s, SB_HEADS, SB_HEAD_DIM)
    o_b = _stick_breaking(b_q.reshape(shp), b_k.reshape(shp), b_v.reshape(shp)).reshape(bsz, s, SB_WIDTH)
    y_b = o_b * jax.nn.silu(b_g)
    y = jnp.concatenate([y_a, y_b], axis=-1)
    return jnp.einsum('bse,ed->bsd', y, w_out)


def _odd_layer(x, w_in, sinks, w_out):
    bsz, s, _ = x.shape
    hproj = jnp.einsum('bsd,de->bse', x, w_in)
    splits = np.cumsum([C_WIDTH, C_KV_WIDTH, C_KV_WIDTH])
    q, k, v, g = jnp.split(hproj, splits, axis=-1)
    o = _swa_sinks_alibi(q.reshape(bsz, s, C_HEADS, C_HEAD_DIM),
                         k.reshape(bsz, s, C_KV_HEADS, C_HEAD_DIM),
                         v.reshape(bsz, s, C_KV_HEADS, C_HEAD_DIM), sinks).reshape(bsz, s, C_WIDTH)
    y = o * jax.nn.silu(g)
    return jnp.einsum('bse,ed->bsd', y, w_out)


def setup_inputs(seed: int = 0) -> dict:
    key = jax.random.key(seed)
    ks = jax.random.split(key, 20)
    f32 = jnp.float32
    nrm = lambda k, shp, sc: jax.random.normal(k, shp, f32) * sc
    x = jax.random.normal(ks[0], (BATCH, SEQ, D_MODEL), f32)
    e_w_in = nrm(ks[1], (N_EVEN, D_MODEL, EVEN_IN), D_MODEL ** -0.5)
    e_conv_w = nrm(ks[2], (N_EVEN, CONV_WIDTH, LRU_WIDTH), CONV_WIDTH ** -0.5)
    e_conv_b = nrm(ks[3], (N_EVEN, LRU_WIDTH), 0.02)
    e_w_gate_a = nrm(ks[4], (N_EVEN, LRU_BLOCKS, LRU_BLOCK, LRU_BLOCK), LRU_BLOCK ** -0.5)
    e_b_gate_a = nrm(ks[5], (N_EVEN, LRU_WIDTH), 0.02)
    e_w_gate_x = nrm(ks[6], (N_EVEN, LRU_BLOCKS, LRU_BLOCK, LRU_BLOCK), LRU_BLOCK ** -0.5)
    e_b_gate_x = nrm(ks[7], (N_EVEN, LRU_WIDTH), 0.02)
    u = jax.random.uniform(ks[8], (N_EVEN, LRU_WIDTH), f32, 0.9, 0.999)
    a0 = u ** (1.0 / LRU_C)
    e_lru_lambda = jnp.log(a0) - jnp.log1p(-a0)
    e_w_out = nrm(ks[9], (N_EVEN, EVEN_MIX, D_MODEL), EVEN_MIX ** -0.5 * DEEPNORM_BETA)
    e_ln_g = 1.0 + nrm(ks[10], (N_EVEN, D_MODEL), 0.02)
    e_ln_b = nrm(ks[11], (N_EVEN, D_MODEL), 0.02)
    o_w_in = nrm(ks[12], (N_ODD, D_MODEL, ODD_IN), D_MODEL ** -0.5)
    o_sinks = nrm(ks[13], (N_ODD, C_HEADS), 1.0)
    o_w_out = nrm(ks[14], (N_ODD, C_WIDTH, D_MODEL), C_WIDTH ** -0.5 * DEEPNORM_BETA)
    o_ln_g = 1.0 + nrm(ks[15], (N_ODD, D_MODEL), 0.02)
    o_ln_b = nrm(ks[16], (N_ODD, D_MODEL), 0.02)
    return {"x": x, "e_w_in": e_w_in, "e_conv_w": e_conv_w, "e_conv_b": e_conv_b,
            "e_w_gate_a": e_w_gate_a, "e_b_gate_a": e_b_gate_a, "e_w_gate_x": e_w_gate_x,
            "e_b_gate_x": e_b_gate_x, "e_lru_lambda": e_lru_lambda, "e_w_out": e_w_out,
            "e_ln_g": e_ln_g, "e_ln_b": e_ln_b, "o_w_in": o_w_in, "o_sinks": o_sinks,
            "o_w_out": o_w_out, "o_ln_g": o_ln_g, "o_ln_b": o_ln_b}


def reference(x, e_w_in, e_conv_w, e_conv_b, e_w_gate_a, e_b_gate_a, e_w_gate_x, e_b_gate_x,
              e_lru_lambda, e_w_out, e_ln_g, e_ln_b, o_w_in, o_sinks, o_w_out, o_ln_g, o_ln_b):
    for layer in range(DEPTH):
        li = layer // 2
        if layer % 2 == 0:
            y = _even_layer(x, e_w_in[li], e_conv_w[li], e_conv_b[li], e_w_gate_a[li], e_b_gate_a[li],
                            e_w_gate_x[li], e_b_gate_x[li], e_lru_lambda[li], e_w_out[li])
            x = _layer_norm(DEEPNORM_ALPHA * x + y, e_ln_g[li], e_ln_b[li])
        else:
            y = _odd_layer(x, o_w_in[li], o_sinks[li], o_w_out[li])
            x = _layer_norm(DEEPNORM_ALPHA * x + y, o_ln_g[li], o_ln_b[li])
    return x
```

```cpp
#include <hip/hip_runtime.h>
#include <hip/hip_cooperative_groups.h>
#include <cstdio>
namespace cg = cooperative_groups;
namespace pg8 {
#define PG8_LAS __attribute__((address_space(3)))
typedef unsigned short bf16_t;
typedef short bf16x8 __attribute__((ext_vector_type(8)));
typedef float f32x4 __attribute__((ext_vector_type(4)));
typedef unsigned u32x4 __attribute__((ext_vector_type(4)));
constexpr int BM = 256, BK = 64, HALF = 128, HTB = HALF * BK * 2  , STAGE_BYTES = 8 * HTB, NXCD = 8, WGM = 8;

__host__ __device__ __forceinline__ int lds_byte(int r, int c) { const int st = (r >> 4) * 2 + (c >> 5), rr = r & 15, cc = c & 31, ob = rr * 64 + cc * 2; return st * 1024 + (ob ^ (((ob >> 9) & 1) << 5)); }
__host__ __device__ __forceinline__ void stage_rc(int b, int& R, int& C) { const int st = b / 1024, sb = b % 1024, swz = sb ^ (((sb >> 9) & 1) << 5); R = (st >> 1) * 16 + swz / 64; C = (st & 1) * 32 + (swz % 64) / 2; }
__host__ __device__ __forceinline__ int perm32(int rho) { const int n = rho >> 4, i = rho & 15; return 8 * (i >> 2) + 4 * n + (i & 3); }

struct Unit { int pm, pn; };
struct Gemm { const bf16_t* A; const bf16_t* Bt; int M, N, K; };

struct StaticOrder {
    int nM, nN, nwg, G, c;
    __host__ __device__ void init(int M, int N, int G_, int c_) { nM = M / BM; nN = N / BM; nwg = nM * nN; G = G_; c = c_; }
    __host__ __device__ bool next(int i, Unit& u) const {
        const long L = (long)i * G + c; if (L >= nwg) return false;
        int wgid = (int)L; { const int q = nwg / NXCD, r = nwg % NXCD, xcd = wgid % NXCD, off = wgid / NXCD; wgid = (xcd < r ? xcd * (q + 1) : r * (q + 1) + (xcd - r) * q) + off; }
        const int nig = WGM * nN, gid = wgid / nig, fm = gid * WGM, gsz = (nM - fm) < WGM ? (nM - fm) : WGM;
        u.pm = fm + ((wgid % nig) % gsz); u.pn = (wgid % nig) / gsz; return true;
    }
    __device__ __forceinline__ void a_ready(const Unit&) const {}
    __device__ __forceinline__ void done(const Unit&) const {}
};

__device__ __forceinline__ unsigned cvt_pk_bf16(float lo, float hi) { unsigned r; asm volatile("v_cvt_pk_bf16_f32 %0, %1, %2" : "=v"(r) : "v"(lo), "v"(hi)); return r; }
typedef float f32x2 __attribute__((ext_vector_type(2)));
struct EpiF32 {
    static constexpr bool PERM = false, AFTER_DRAIN = false;
    float* C; int ldc; const float* bias;
    __device__ __forceinline__ void operator()(const f32x4 (&acc)[2][2][4][2], const Unit& u, int wr, int wc, int fr, int fq) const {
        const int row0 = u.pm * BM + wr * 64 + fr, col0 = u.pn * BM + wc * 32 + 4 * fq;
        f32x4 bv[2][2];
#pragma unroll
        for (int bj = 0; bj < 2; ++bj)
#pragma unroll
            for (int n = 0; n < 2; ++n) bv[bj][n] = bias ? *(const f32x4*)(bias + col0 + bj * HALF + n * 16) : (f32x4){0.f, 0.f, 0.f, 0.f};
#pragma unroll
        for (int ai = 0; ai < 2; ++ai)
#pragma unroll
            for (int m = 0; m < 4; ++m) { float* rowp = C + (size_t)(row0 + ai * HALF + m * 16) * ldc + col0;
#pragma unroll
                for (int bj = 0; bj < 2; ++bj)
#pragma unroll
                    for (int n = 0; n < 2; ++n) *(f32x4*)(rowp + bj * HALF + n * 16) = acc[ai][bj][m][n] + bv[bj][n]; }
    }
};
struct EpiResF32 {
    static constexpr bool PERM = false, AFTER_DRAIN = false;
    float* C; int ldc; const float* R; float alpha;
    __device__ __forceinline__ void operator()(const f32x4 (&acc)[2][2][4][2], const Unit& u, int wr, int wc, int fr, int fq) const {
        const int row0 = u.pm * BM + wr * 64 + fr, col0 = u.pn * BM + wc * 32 + 4 * fq;
#pragma unroll
        for (int ai = 0; ai < 2; ++ai)
#pragma unroll
            for (int m = 0; m < 4; ++m) { const size_t off = (size_t)(row0 + ai * HALF + m * 16) * ldc + col0;
#pragma unroll
                for (int bj = 0; bj < 2; ++bj)
#pragma unroll
                    for (int n = 0; n < 2; ++n) { const f32x4 rv = *(const f32x4*)(R + off + bj * HALF + n * 16); *(f32x4*)(C + off + bj * HALF + n * 16) = acc[ai][bj][m][n] + rv * alpha; } }
    }
};
template <int ACT  > struct EpiBf16 {
    static constexpr bool PERM = true, AFTER_DRAIN = false;
    bf16_t* O; int ldc; const float* bias; int split_cols; size_t split_stride;
    __device__ __forceinline__ void operator()(const f32x4 (&acc)[2][2][4][2], const Unit& u, int wr, int wc, int fr, int fq) const {
        const int row0 = u.pm * BM + wr * 64 + fr; int colt = u.pn * BM; bf16_t* base = O;
        if (split_cols) { const int t = colt / split_cols; base += (size_t)t * split_stride; colt -= t * split_cols; }
        const int col0 = colt + wc * 32 + 8 * fq, bcol0 = u.pn * BM + wc * 32 + 8 * fq;
        f32x4 bv[2][2];
#pragma unroll
        for (int bj = 0; bj < 2; ++bj)
#pragma unroll
            for (int n = 0; n < 2; ++n) bv[bj][n] = bias ? *(const f32x4*)(bias + bcol0 + bj * HALF + 4 * n) : (f32x4){0.f, 0.f, 0.f, 0.f};
#pragma unroll
        for (int ai = 0; ai < 2; ++ai)
#pragma unroll
            for (int m = 0; m < 4; ++m) { bf16_t* rowp = base + (size_t)(row0 + ai * HALF + m * 16) * ldc + col0;
#pragma unroll
                for (int bj = 0; bj < 2; ++bj) { f32x4 v0 = acc[ai][bj][m][0] + bv[bj][0], v1 = acc[ai][bj][m][1] + bv[bj][1];
                    u32x4 w; w.x = cvt_pk_bf16(v0[0], v0[1]); w.y = cvt_pk_bf16(v0[2], v0[3]); w.z = cvt_pk_bf16(v1[0], v1[1]); w.w = cvt_pk_bf16(v1[2], v1[3]);
                    *(u32x4*)(rowp + bj * HALF) = w; } }
    }
};
template <class Epi, class Sched, bool STAMP = false>
__device__ __forceinline__ void gemm_phase(PG8_LAS unsigned char* lds, const Gemm g, const Sched& S, const Epi& E, unsigned long long* stamps) {
    const int tid = threadIdx.x, wid = __builtin_amdgcn_readfirstlane(tid >> 6), lane = tid & 63, wr = wid >> 2, wc = wid & 3, fr = lane & 15, fq = lane >> 4;
    const int K = g.K, nt = K / BK;
    int ts_lo = 0, ts_hi = 0, nts = 0; const unsigned long long rt_entry = STAMP ? (unsigned long long)wall_clock64() : 0ull;
#define PG8_STAMP() do { if (STAMP && wid == 0 && nts < 64) { const unsigned long long _c = (unsigned long long)clock64(); \
        ts_lo = (lane == nts) ? (int)(unsigned)_c : ts_lo; ts_hi = (lane == nts) ? (int)(unsigned)(_c >> 32) : ts_hi; ++nts; } } while (0)
    PG8_STAMP();
    unsigned voffA[2], voffB[2];
#pragma unroll
    for (int i = 0; i < 2; ++i) { int R, C; stage_rc(tid * 16 + i * 8192, R, C); const int Rb = Epi::PERM ? ((R & ~31) + perm32(R & 31)) : R;
        voffA[i] = (unsigned)(R * K + C) * 2u; voffB[i] = (unsigned)(Rb * K + C) * 2u; }
    const size_t kstep = (size_t)(BK * 2);
    const size_t hstep = (size_t)HALF * K * 2;
    const size_t tstep = 2 * hstep;
    const unsigned ldsw = (unsigned)wid * 1024u;
    const int aoff = lds_byte(wr * 64 + fr, fq * 8), boff = lds_byte(wc * 32 + fr, fq * 8);
#define PG8_SA(b, h) (((b) * 2 + (h)) * HTB)
#define PG8_SB(b, h) ((4 + (b) * 2 + (h)) * HTB)
#define PG8_STAGE(bufoff, gbase, voff) do { _Pragma("unroll") for (int _i = 0; _i < 2; ++_i) \
        __builtin_amdgcn_global_load_lds((const unsigned*)((const char*)(gbase) + (voff)[_i]), (PG8_LAS unsigned*)(lds + (bufoff) + ldsw + _i * 8192), 16, 0, 0); } while (0)
#define PG8_LDA(dst, b, h) do { _Pragma("unroll") for (int m = 0; m < 4; ++m) _Pragma("unroll") for (int k = 0; k < 2; ++k) dst[m][k] = *(const PG8_LAS bf16x8*)(lds + PG8_SA(b, h) + aoff + m * 2048 + k * 1024); } while (0)
#define PG8_LDB(dst, b, h) do { _Pragma("unroll") for (int n = 0; n < 2; ++n) _Pragma("unroll") for (int k = 0; k < 2; ++k) dst[n][k] = *(const PG8_LAS bf16x8*)(lds + PG8_SB(b, h) + boff + n * 2048 + k * 1024); } while (0)
#define PG8_MMA(ai, bj, At, Bt) do { __builtin_amdgcn_s_setprio(1); _Pragma("unroll") for (int m = 0; m < 4; ++m) _Pragma("unroll") for (int n = 0; n < 2; ++n) _Pragma("unroll") for (int k = 0; k < 2; ++k) \
        acc[ai][bj][m][n] = __builtin_amdgcn_mfma_f32_16x16x32_bf16(Bt[n][k], At[m][k], acc[ai][bj][m][n], 0, 0, 0); __builtin_amdgcn_s_setprio(0); } while (0)
#define PG8_WAIT_V(n) asm volatile("s_waitcnt vmcnt(" #n ")" ::: "memory")
#define PG8_WAIT_L(n) asm volatile("s_waitcnt lgkmcnt(" #n ")" ::: "memory")
#define PG8_BAR __builtin_amdgcn_s_barrier()
#define PG8_SCHED __builtin_amdgcn_sched_barrier(0)
    Unit cur, nxt; int ui = 0;
    if (!S.next(0, cur)) return;
    f32x4 acc[2][2][4][2];
#pragma unroll
    for (int a = 0; a < 2; ++a)
#pragma unroll
        for (int b = 0; b < 2; ++b)
#pragma unroll
            for (int m = 0; m < 4; ++m)
#pragma unroll
                for (int n = 0; n < 2; ++n) acc[a][b][m][n] = (f32x4){0.f, 0.f, 0.f, 0.f};
    bf16x8 At[4][2], B0[2][2], B1[2][2];
    const char* cA = (const char*)g.A + (size_t)cur.pm * tstep; const char* cB = (const char*)g.Bt + (size_t)cur.pn * tstep;
    S.a_ready(cur);
    PG8_STAGE(PG8_SB(0, 0), cB, voffB); PG8_STAGE(PG8_SA(0, 0), cA, voffA); PG8_STAGE(PG8_SB(0, 1), cB + hstep, voffB); PG8_STAGE(PG8_SA(0, 1), cA + hstep, voffA);
    if (wr == 1) PG8_BAR;
    PG8_WAIT_V(4); PG8_BAR;
    PG8_STAGE(PG8_SB(1, 0), cB + kstep, voffB); PG8_STAGE(PG8_SA(1, 0), cA + kstep, voffA); PG8_STAGE(PG8_SB(1, 1), cB + hstep + kstep, voffB);
    PG8_WAIT_V(6); PG8_BAR;
    PG8_STAMP();
    for (;;) {
        const bool has_next = S.next(ui + 1, nxt);
        const char* nA = has_next ? (const char*)g.A + (size_t)nxt.pm * tstep : cA; const char* nB = has_next ? (const char*)g.Bt + (size_t)nxt.pn * tstep : cB;
        for (int t = 0; t < nt; t += 2) {
            const bool last = (t == nt - 2);
            const char* a1 = cA + (size_t)(t + 1) * kstep;
            const char* a2 = last ? nA : cA + (size_t)(t + 2) * kstep; const char* b2 = last ? nB : cB + (size_t)(t + 2) * kstep;
            const char* a3 = a2 + kstep; const char* b3 = b2 + kstep;
            if (last && has_next) S.a_ready(nxt);
            PG8_LDB(B0, 0, 0); PG8_SCHED; PG8_LDA(At, 0, 0); PG8_STAGE(PG8_SA(1, 1), a1 + hstep, voffA);
            PG8_WAIT_L(8); PG8_BAR; PG8_WAIT_L(0); PG8_MMA(0, 0, At, B0); PG8_BAR; PG8_SCHED;
            PG8_LDB(B1, 0, 1); PG8_STAGE(PG8_SB(0, 0), b2, voffB);
            PG8_BAR; PG8_WAIT_L(0); PG8_MMA(0, 1, At, B1); PG8_BAR;
            PG8_LDA(At, 0, 1); PG8_STAGE(PG8_SA(0, 0), a2, voffA);
            PG8_BAR; PG8_WAIT_L(0); PG8_MMA(1, 0, At, B0); PG8_BAR; PG8_SCHED;
            PG8_STAGE(PG8_SB(0, 1), b2 + hstep, voffB);
            PG8_WAIT_V(6); PG8_BAR; PG8_MMA(1, 1, At, B1); PG8_BAR;
            PG8_LDB(B0, 1, 0); PG8_SCHED; PG8_LDA(At, 1, 0); PG8_STAGE(PG8_SA(0, 1), a2 + hstep, voffA);
            PG8_WAIT_L(8); PG8_BAR; PG8_WAIT_L(0); PG8_MMA(0, 0, At, B0); PG8_BAR; PG8_SCHED;
            PG8_LDB(B1, 1, 1); PG8_STAGE(PG8_SB(1, 0), b3, voffB);
            PG8_BAR; PG8_WAIT_L(0); PG8_MMA(0, 1, At, B1); PG8_BAR;
            PG8_LDA(At, 1, 1); PG8_STAGE(PG8_SA(1, 0), a3, voffA);
            PG8_BAR; PG8_WAIT_L(0); PG8_MMA(1, 0, At, B0); PG8_BAR; PG8_SCHED;
            PG8_STAGE(PG8_SB(1, 1), b3 + hstep, voffB);
            PG8_WAIT_V(6); PG8_BAR; PG8_MMA(1, 1, At, B1); PG8_BAR;
        }
        PG8_STAMP();
        if constexpr (!Epi::AFTER_DRAIN) { E(acc, cur, wr, wc, fr, fq); S.done(cur); }
        PG8_STAMP();
        if (!has_next) break;
#pragma unroll
        for (int a = 0; a < 2; ++a)
#pragma unroll
            for (int b = 0; b < 2; ++b)
#pragma unroll
                for (int m = 0; m < 4; ++m)
#pragma unroll
                    for (int n = 0; n < 2; ++n) acc[a][b][m][n] = (f32x4){0.f, 0.f, 0.f, 0.f};
        cur = nxt; cA = nA; cB = nB; ++ui;
    }
    PG8_WAIT_V(0);
    if (wr == 0) PG8_BAR;
    PG8_BAR;
    if constexpr (Epi::AFTER_DRAIN) { E.fused(acc, cur, wr, wc, fr, fq, lds, wid, lane); S.done(cur); }
    PG8_STAMP();
    if (STAMP && wid == 0) { stamps[lane] = lane < nts ? (((unsigned long long)(unsigned)ts_hi << 32) | (unsigned)ts_lo) : 0ull;
        if (lane == 62) stamps[62] = rt_entry; if (lane == 63) stamps[63] = (unsigned long long)wall_clock64(); }
#undef PG8_STAMP
#undef PG8_SA
#undef PG8_SB
#undef PG8_STAGE
#undef PG8_LDA
#undef PG8_LDB
#undef PG8_MMA
#undef PG8_WAIT_V
#undef PG8_WAIT_L
#undef PG8_BAR
#undef PG8_SCHED
}
}

#define LAS __attribute__((address_space(3)))
typedef unsigned short bf16_t;
typedef short bf16x8 __attribute__((ext_vector_type(8)));
typedef float f32x4 __attribute__((ext_vector_type(4)));
typedef float f32x2 __attribute__((ext_vector_type(2)));
typedef float f32x16 __attribute__((ext_vector_type(16)));
typedef unsigned u32x4 __attribute__((ext_vector_type(4)));
typedef unsigned u32x2 __attribute__((ext_vector_type(2)));

constexpr int NTOK = 32768, SEQ = 8192, DM = 1024;
constexpr int H0W = 5120;
constexpr int H1W = 2304;
constexpr float ALPHA = 1.4142135623730951f;
constexpr float LN_EPS = 1e-5f;
constexpr size_t MiB = 1ull << 20;
constexpr size_t WS_W0T = 0;
constexpr size_t WS_WO0T = 12 * MiB;
constexpr size_t WS_W1T = 16 * MiB;
constexpr size_t WS_WO1T = 21 * MiB;
constexpr size_t WS_WGT = 23 * MiB;
constexpr size_t WS_SUM = 24 * MiB;
constexpr size_t WS_XB = 32 * MiB;
constexpr size_t WS_VT0 = 96 * MiB;
constexpr size_t WS_H0 = 160 * MiB;
constexpr size_t WS_END = 480 * MiB;

struct Params { const float* in[17]; float* out; unsigned char* ws; int ph_lo, ph_hi; };

__device__ __forceinline__ unsigned pk2(float lo, float hi) { return pg8::cvt_pk_bf16(lo, hi); }
__device__ __forceinline__ float bflo(unsigned v) { return __uint_as_float(v << 16); }
__device__ __forceinline__ float bfhi(unsigned v) { return __uint_as_float(v & 0xffff0000u); }
__device__ __forceinline__ float fsigmoid(float x) { return __builtin_amdgcn_rcpf(1.0f + __expf(-x)); }
__device__ __forceinline__ float fsilu(float x) { return x * fsigmoid(x); }
__device__ __forceinline__ float wave_sum(float v) {
#pragma unroll
    for (int o = 32; o >= 1; o >>= 1) v += __shfl_xor(v, o);
    return v; }
__device__ __forceinline__ int pi32(int r) { return (r & 0x13) | ((r & 4) << 1) | ((r & 8) >> 1); }
#define MFMA32(a, b, c) __builtin_amdgcn_mfma_f32_32x32x16_bf16((a), (b), (c), 0, 0, 0)

__device__ __forceinline__ void cvt_x(const float* __restrict__ x, bf16_t* __restrict__ xb, size_t gtid, size_t gthreads) {
    for (size_t i = gtid; i < (size_t)NTOK * DM / 8; i += gthreads) {
        const f32x4 a = *(const f32x4*)(x + i * 8), b = *(const f32x4*)(x + i * 8 + 4);
        u32x4 w; w.x = pk2(a[0], a[1]); w.y = pk2(a[2], a[3]); w.z = pk2(b[0], b[1]); w.w = pk2(b[2], b[3]);
        *(u32x4*)(xb + i * 8) = w; }
}
__device__ __forceinline__ void tr_cvt(const float* __restrict__ src, int ld, int K, int scol0, int ncols, bf16_t* __restrict__ dst, int drow0, LAS float* T, int blk, int nblk) {
    const int tid = threadIdx.x, tk = K / 64, tn = ncols / 64;
    for (int t = blk; t < tk * tn; t += nblk) {
        const int k0 = (t % tk) * 64, n0 = (t / tk) * 64;
        __syncthreads();
#pragma unroll
        for (int i = 0; i < 2; ++i) { const int kr = (tid >> 4) + 32 * i, c4 = (tid & 15) * 4;
            const f32x4 v = *(const f32x4*)(src + (size_t)(k0 + kr) * ld + scol0 + n0 + c4);
            T[kr * 65 + c4] = v[0]; T[kr * 65 + c4 + 1] = v[1]; T[kr * 65 + c4 + 2] = v[2]; T[kr * 65 + c4 + 3] = v[3]; }
        __syncthreads();
        { const int n = tid >> 3, k8 = (tid & 7) * 8; float v[8];
#pragma unroll
            for (int j = 0; j < 8; ++j) v[j] = T[(k8 + j) * 65 + n];
            u32x4 w; w.x = pk2(v[0], v[1]); w.y = pk2(v[2], v[3]); w.z = pk2(v[4], v[5]); w.w = pk2(v[6], v[7]);
            *(u32x4*)(dst + (size_t)(drow0 + n0 + n) * K + k0 + k8) = w; }
    }
}

__device__ __forceinline__ void ln_phase(const float* z, float* of, bf16_t* ob, const float* __restrict__ g, const float* __restrict__ bta, int gwave, int ngwaves, int lane) {
    f32x4 gv[4], bv[4];
#pragma unroll
    for (int i = 0; i < 4; ++i) { gv[i] = *(const f32x4*)(g + i * 256 + lane * 4); bv[i] = *(const f32x4*)(bta + i * 256 + lane * 4); }
    for (int row = gwave; row < NTOK; row += ngwaves) {
        const float* zr = z + (size_t)row * DM; f32x4 v[4];
#pragma unroll
        for (int i = 0; i < 4; ++i) v[i] = *(const f32x4*)(zr + i * 256 + lane * 4);
        float s = 0.f;
#pragma unroll
        for (int i = 0; i < 4; ++i) s += (v[i][0] + v[i][1]) + (v[i][2] + v[i][3]);
        const float mean = wave_sum(s) * (1.0f / 1024.0f);
        float q = 0.f;
#pragma unroll
        for (int i = 0; i < 4; ++i) { const f32x4 d = v[i] - mean; q += (d[0] * d[0] + d[1] * d[1]) + (d[2] * d[2] + d[3] * d[3]); }
        const float rstd = rsqrtf(wave_sum(q) * (1.0f / 1024.0f) + LN_EPS);
#pragma unroll
        for (int i = 0; i < 4; ++i) { const f32x4 y = (v[i] - mean) * rstd * gv[i] + bv[i];
            *(f32x4*)(of + (size_t)row * DM + i * 256 + lane * 4) = y;
            if (ob) { u32x2 w; w.x = pk2(y[0], y[1]); w.y = pk2(y[2], y[3]); *(u32x2*)(ob + (size_t)row * DM + i * 256 + lane * 4) = w; } }
    }
}

__device__ __forceinline__ void sb_task(const bf16_t* __restrict__ H0, const bf16_t* __restrict__ VT, bf16_t* __restrict__ Y0, int b, int h, int qt, int lane) {
    const int r = lane & 31, hh = lane >> 5, pr = pi32(r), q0 = qt * 32;
    const size_t tb = (size_t)b * SEQ;
    const float SCALE = 0.08838834764831845f;
    bf16x8 qf[8];
    { const bf16_t* qrow = H0 + (tb + q0 + r) * H0W + 2048 + h * 128 + 8 * hh;
#pragma unroll
      for (int s = 0; s < 8; ++s) qf[s] = *(const bf16x8*)(qrow + 16 * s); }
    bf16x8 uf[2];
#pragma unroll
    for (int s = 0; s < 2; ++s)
#pragma unroll
        for (int j = 0; j < 8; ++j) uf[s][j] = (16 * s + 8 * hh + j > pr) ? (short)0x3F80 : (short)0;
    f32x16 o[4];
#pragma unroll
    for (int dt = 0; dt < 4; ++dt)
#pragma unroll
        for (int i = 0; i < 16; ++i) o[dt][i] = 0.f;
    float carry = 0.f;
    const bf16_t* vbase = VT + (size_t)(h * 128 + r) * NTOK + tb + 8 * hh;
    for (int kb = qt; kb >= 0; --kb) {
        const int k0 = kb * 32;
        const bf16_t* krow = H0 + (tb + k0 + pr) * H0W + 3072 + h * 128 + 8 * hh;
        f32x16 st;
#pragma unroll
        for (int i = 0; i < 16; ++i) st[i] = 0.f;
#pragma unroll
        for (int s = 0; s < 8; ++s) { const bf16x8 kf = *(const bf16x8*)(krow + 16 * s); st = MFMA32(kf, qf[s], st); }
        bf16x8 vf[4][2];
#pragma unroll
        for (int dt = 0; dt < 4; ++dt)
#pragma unroll
            for (int s = 0; s < 2; ++s) vf[dt][s] = *(const bf16x8*)(vbase + (size_t)(32 * dt) * NTOK + k0 + 16 * s);
        const bool diag = (kb == qt);
        float L[16], lb[16]; float psum = 0.f;
#pragma unroll
        for (int i = 0; i < 16; ++i) {
            const float z = st[i] * SCALE;
            const float sp = fmaxf(z, 0.f) + __logf(1.0f + __expf(-fabsf(z)));
            const int key = 16 * (i >> 3) + 8 * hh + (i & 7);
            const bool valid = !diag || (key < r);
            L[i] = valid ? -sp : 0.f; lb[i] = valid ? (z - sp) : -1e30f; psum += L[i]; }
        const float tot = psum + __shfl_xor(psum, 32);
        union { bf16x8 v; unsigned u[4]; } hi[2], lo[2], pf[2];
#pragma unroll
        for (int s = 0; s < 2; ++s)
#pragma unroll
            for (int jj = 0; jj < 4; ++jj) { const float a0 = L[8 * s + 2 * jj], a1 = L[8 * s + 2 * jj + 1];
                const unsigned ph = pk2(a0, a1); hi[s].u[jj] = ph; lo[s].u[jj] = pk2(a0 - bflo(ph), a1 - bfhi(ph)); }
        f32x16 suf;
#pragma unroll
        for (int i = 0; i < 16; ++i) suf[i] = 0.f;
#pragma unroll
        for (int s = 0; s < 2; ++s) { suf = MFMA32(uf[s], hi[s].v, suf); suf = MFMA32(uf[s], lo[s].v, suf); }
        float w[16];
#pragma unroll
        for (int i = 0; i < 16; ++i) w[i] = __expf(lb[i] + suf[i] + carry);
        carry += tot;
#pragma unroll
        for (int s = 0; s < 2; ++s)
#pragma unroll
            for (int jj = 0; jj < 4; ++jj) pf[s].u[jj] = pk2(w[8 * s + 2 * jj], w[8 * s + 2 * jj + 1]);
#pragma unroll
        for (int dt = 0; dt < 4; ++dt)
#pragma unroll
            for (int s = 0; s < 2; ++s) o[dt] = MFMA32(vf[dt][s], pf[s].v, o[dt]);
        if (__all(carry < -110.0f)) break;
    }
    const size_t tok = tb + q0 + r;
#pragma unroll
    for (int dt = 0; dt < 4; ++dt)
#pragma unroll
        for (int g4 = 0; g4 < 4; ++g4) { const int d0 = 32 * dt + 8 * g4 + 4 * hh;
            const u32x2 gv = *(const u32x2*)(H0 + tok * H0W + 4096 + h * 128 + d0);
            const float y0 = o[dt][4 * g4] * fsilu(bflo(gv.x)), y1 = o[dt][4 * g4 + 1] * fsilu(bfhi(gv.x)), y2 = o[dt][4 * g4 + 2] * fsilu(bflo(gv.y)), y3 = o[dt][4 * g4 + 3] * fsilu(bfhi(gv.y));
            u32x2 wv; wv.x = pk2(y0, y1); wv.y = pk2(y2, y3);
            *(u32x2*)(Y0 + tok * 2048 + 1024 + h * 128 + d0) = wv; }
}

__device__ __forceinline__ void swa_task(const bf16_t* __restrict__ H1, const bf16_t* __restrict__ KVT, const float* __restrict__ sinks, bf16_t* __restrict__ Y1, int b, int c, int hc, int qt, int lane) {
    const int r = lane & 31, hh = lane >> 5, pr = pi32(r), q0 = qt * 32;
    const size_t tb = (size_t)b * SEQ;
    const float slope = exp2f(-0.5f * (float)(hc + 1)), sink = sinks[hc];
    bf16x8 qf[4];
    { const bf16_t* qrow = H1 + (tb + q0 + r) * H1W + hc * 64 + 8 * hh;
#pragma unroll
      for (int s = 0; s < 4; ++s) qf[s] = *(const bf16x8*)(qrow + 16 * s); }
    f32x16 o[2];
#pragma unroll
    for (int dt = 0; dt < 2; ++dt)
#pragma unroll
        for (int i = 0; i < 16; ++i) o[dt][i] = 0.f;
    float m = sink, l = 1.0f;
    const bf16_t* vbase = KVT + (size_t)(128 + c * 64 + r) * NTOK + tb + 8 * hh;
    const int kb_lo = qt - 4 < 0 ? 0 : qt - 4;
    for (int kb = kb_lo; kb <= qt; ++kb) {
        const int k0 = kb * 32;
        const bf16_t* krow = H1 + (tb + k0 + pr) * H1W + 1024 + c * 64 + 8 * hh;
        f32x16 st;
#pragma unroll
        for (int i = 0; i < 16; ++i) st[i] = 0.f;
#pragma unroll
        for (int s = 0; s < 4; ++s) { const bf16x8 kf = *(const bf16x8*)(krow + 16 * s); st = MFMA32(kf, qf[s], st); }
        bf16x8 vf[2][2];
#pragma unroll
        for (int dt = 0; dt < 2; ++dt)
#pragma unroll
            for (int s = 0; s < 2; ++s) vf[dt][s] = *(const bf16x8*)(vbase + (size_t)(32 * dt) * NTOK + k0 + 16 * s);
        float sc[16]; float bmax = -1e30f;
#pragma unroll
        for (int i = 0; i < 16; ++i) { const int key = k0 + 16 * (i >> 3) + 8 * hh + (i & 7); const int dist = q0 + r - key;
            const bool valid = dist >= 0 && dist < 128;
            sc[i] = valid ? (st[i] * 0.125f - slope * (float)dist) : -1e30f; bmax = fmaxf(bmax, sc[i]); }
        bmax = fmaxf(bmax, __shfl_xor(bmax, 32));
        const float mn = fmaxf(m, bmax), al = __expf(m - mn);
        float psum = 0.f; float p[16];
#pragma unroll
        for (int i = 0; i < 16; ++i) { p[i] = __expf(sc[i] - mn); psum += p[i]; }
        psum += __shfl_xor(psum, 32);
        l = l * al + psum; m = mn;
#pragma unroll
        for (int dt = 0; dt < 2; ++dt)
#pragma unroll
            for (int i = 0; i < 16; ++i) o[dt][i] *= al;
        union { bf16x8 v; unsigned u[4]; } pf[2];
#pragma unroll
        for (int s = 0; s < 2; ++s)
#pragma unroll
            for (int jj = 0; jj < 4; ++jj) pf[s].u[jj] = pk2(p[8 * s + 2 * jj], p[8 * s + 2 * jj + 1]);
#pragma unroll
        for (int dt = 0; dt < 2; ++dt)
#pragma unroll
            for (int s = 0; s < 2; ++s) o[dt] = MFMA32(vf[dt][s], pf[s].v, o[dt]);
    }
    const float inv = __builtin_amdgcn_rcpf(l);
    const size_t tok = tb + q0 + r;
#pragma unroll
    for (int dt = 0; dt < 2; ++dt)
#pragma unroll
        for (int g4 = 0; g4 < 4; ++g4) { const int d0 = 32 * dt + 8 * g4 + 4 * hh;
            const u32x2 gv = *(const u32x2*)(H1 + tok * H1W + 1280 + hc * 64 + d0);
            const float y0 = o[dt][4 * g4] * inv * fsilu(bflo(gv.x)), y1 = o[dt][4 * g4 + 1] * inv * fsilu(bfhi(gv.x)), y2 = o[dt][4 * g4 + 2] * inv * fsilu(bflo(gv.y)), y3 = o[dt][4 * g4 + 3] * inv * fsilu(bfhi(gv.y));
            u32x2 wv; wv.x = pk2(y0, y1); wv.y = pk2(y2, y3);
            *(u32x2*)(Y1 + tok * 1024 + hc * 64 + d0) = wv; }
}

constexpr int LRU_XCB = 0, LRU_XCF = 17408, LRU_AF = LRU_XCF + 32768, LRU_UF = LRU_AF + 32768;
template <int PASS>
__device__ __forceinline__ void lru_item(const Params& p, LAS unsigned char* lds, int item) {
    const int tid = threadIdx.x, lane = tid & 63, wid = tid >> 6;
    const int pair = item & 31, seg = item >> 5, b = pair >> 3, n = pair & 7;
    const size_t tb = (size_t)b * SEQ;
    const bf16_t* H0 = (const bf16_t*)(p.ws + WS_H0); const bf16_t* WGT = (const bf16_t*)(p.ws + WS_WGT);
    f32x2* SUM = (f32x2*)(p.ws + WS_SUM); bf16_t* Y0 = (bf16_t*)p.out;
    LAS bf16_t* XCB = (LAS bf16_t*)(lds + LRU_XCB); LAS float* XCF = (LAS float*)(lds + LRU_XCF); LAS float* AF = (LAS float*)(lds + LRU_AF); LAS float* UF = (LAS float*)(lds + LRU_UF);
    const int r = lane & 31, hh = lane >> 5, ct = wid & 3, tt = wid >> 2;
    bf16x8 wa[8], wx[8];
    { const bf16_t* wga = WGT + ((size_t)(n) * 128 + 32 * ct + r) * 128 + 8 * hh; const bf16_t* wgx = WGT + ((size_t)(8 + n) * 128 + 32 * ct + r) * 128 + 8 * hh;
#pragma unroll
      for (int s = 0; s < 8; ++s) { wa[s] = *(const bf16x8*)(wga + 16 * s); wx[s] = *(const bf16x8*)(wgx + 16 * s); } }
    const int che = n * 128 + 32 * ct + r;
    const float ba = p.in[5][che], bx = p.in[7][che], lam = p.in[8][che];
    const float c8 = -8.0f * (fmaxf(-lam, 0.f) + log1pf(expf(-fabsf(lam))));
    const int ch2 = (tid & 63) * 2, tg = tid >> 6;
    float cw[4][2], cb[2];
#pragma unroll
    for (int k = 0; k < 4; ++k) { cw[k][0] = p.in[2][k * 1024 + n * 128 + ch2]; cw[k][1] = p.in[2][k * 1024 + n * 128 + ch2 + 1]; }
    cb[0] = p.in[3][n * 128 + ch2]; cb[1] = p.in[3][n * 128 + ch2 + 1];
    float hst = 0.f, Pst = 1.f;
    if (PASS == 2 && tid < 128) { for (int sg = 0; sg < seg; ++sg) { const f32x2 sv = SUM[(size_t)(b * 8 + sg) * 1024 + n * 128 + tid]; hst = sv.x * hst + sv.y; } }
    for (int c = 0; c < 16; ++c) {
        const int t0 = seg * 1024 + c * 64;
        __syncthreads();
        { float xa[11][2];
#pragma unroll
          for (int i = 0; i < 11; ++i) { const int t = t0 + tg * 8 - 3 + i; const unsigned v = (t >= 0) ? *(const unsigned*)(H0 + (tb + t) * H0W + n * 128 + ch2) : 0u; xa[i][0] = bflo(v); xa[i][1] = bfhi(v); }
#pragma unroll
          for (int i = 0; i < 8; ++i) { const int tl = tg * 8 + i;
              const float x0 = cb[0] + cw[0][0] * xa[i][0] + cw[1][0] * xa[i + 1][0] + cw[2][0] * xa[i + 2][0] + cw[3][0] * xa[i + 3][0];
              const float x1 = cb[1] + cw[0][1] * xa[i][1] + cw[1][1] * xa[i + 1][1] + cw[2][1] * xa[i + 2][1] + cw[3][1] * xa[i + 3][1];
              *(LAS f32x2*)(XCF + tl * 128 + ch2) = (f32x2){x0, x1}; *(LAS unsigned*)(XCB + tl * 136 + ch2) = pk2(x0, x1); } }
        __syncthreads();
        f32x16 ar, ai;
#pragma unroll
        for (int i = 0; i < 16; ++i) { ar[i] = 0.f; ai[i] = 0.f; }
#pragma unroll
        for (int s = 0; s < 8; ++s) { const bf16x8 af = *(const LAS bf16x8*)(XCB + (32 * tt + r) * 136 + 16 * s + 8 * hh); ar = MFMA32(af, wa[s], ar); ai = MFMA32(af, wx[s], ai); }
#pragma unroll
        for (int i = 0; i < 16; ++i) { const int tl = 32 * tt + (i & 3) + 8 * (i >> 2) + 4 * hh, cl = 32 * ct + r;
            const float rg = fsigmoid(ar[i] + ba), ig = fsigmoid(ai[i] + bx), la = rg * c8, a = __expf(la), y2 = 2.0f * la;
            float pp = 1.0f / 5040.0f; pp = pp * y2 + 1.0f / 720.0f; pp = pp * y2 + 1.0f / 120.0f; pp = pp * y2 + 1.0f / 24.0f; pp = pp * y2 + 1.0f / 6.0f; pp = pp * y2 + 0.5f; pp = pp * y2 + 1.0f;
            const float om = (y2 > -0.25f) ? (-y2 * pp) : (1.0f - __expf(y2));
            AF[tl * 128 + cl] = a; UF[tl * 128 + cl] = sqrtf(om) * ig * XCF[tl * 128 + cl]; }
        __syncthreads();
        if (tid < 128) {
#pragma unroll 16
            for (int t = 0; t < 64; ++t) { const float a = AF[t * 128 + tid], u = UF[t * 128 + tid]; hst = a * hst + u; if (PASS == 1) Pst *= a; if (PASS == 2) UF[t * 128 + tid] = hst; } }
        if (PASS == 2) { __syncthreads();
#pragma unroll
            for (int i = 0; i < 8; ++i) { const int tl = tg * 8 + i; const f32x2 hv = *(const LAS f32x2*)(UF + tl * 128 + ch2);
                const unsigned gv = *(const unsigned*)(H0 + (tb + t0 + tl) * H0W + 1024 + n * 128 + ch2);
                *(unsigned*)(Y0 + (tb + t0 + tl) * 2048 + n * 128 + ch2) = pk2(hv.x * fsilu(bflo(gv)), hv.y * fsilu(bfhi(gv))); } }
    }
    if (PASS == 1 && tid < 128) SUM[(size_t)(b * 8 + seg) * 1024 + n * 128 + tid] = (f32x2){Pst, hst};
}

constexpr int LDS_BYTES = pg8::STAGE_BYTES;
constexpr int N_PHASES = 10;
__global__ void __launch_bounds__(512) mk_fwd(Params p) {
    extern __shared__ __attribute__((aligned(16))) unsigned char lds_raw[];
    LAS unsigned char* lds = (LAS unsigned char*)lds_raw;
    const int tid = threadIdx.x, lane = tid & 63, wid = tid >> 6, G = gridDim.x, bx = blockIdx.x;
    unsigned char* ws = p.ws;
    bf16_t* W0T = (bf16_t*)(ws + WS_W0T); bf16_t* WO0T = (bf16_t*)(ws + WS_WO0T); bf16_t* W1T = (bf16_t*)(ws + WS_W1T); bf16_t* WO1T = (bf16_t*)(ws + WS_WO1T); bf16_t* WGT = (bf16_t*)(ws + WS_WGT);
    bf16_t* XB = (bf16_t*)(ws + WS_XB); bf16_t* VT0 = (bf16_t*)(ws + WS_VT0); bf16_t* H0 = (bf16_t*)(ws + WS_H0);
    float* X1 = (float*)(ws + WS_H0); bf16_t* X1B = XB; bf16_t* H1 = (bf16_t*)(ws + WS_H0 + 128 * MiB); bf16_t* KVT1 = (bf16_t*)(ws + WS_H0 + 272 * MiB); bf16_t* Y1 = VT0;
    bf16_t* Y0 = (bf16_t*)p.out;
    const int lo = p.ph_lo, hi = p.ph_hi;
#define IN(k) (lo <= (k) && (k) < hi)
#define SEAM(k) do { if (IN(k) && IN((k) + 1)) cg::this_grid().sync(); } while (0)

    if (IN(0)) {
        cvt_x(p.in[0], XB, (size_t)bx * 512 + tid, (size_t)G * 512);
        LAS float* T = (LAS float*)lds;
        tr_cvt(p.in[1], 6144, 1024, 0, 4096, W0T, 0, T, bx, G);
        tr_cvt(p.in[1], 6144, 1024, 5120, 1024, W0T, 4096, T, bx, G);
        tr_cvt(p.in[1], 6144, 1024, 4096, 1024, W0T, 5120, T, bx, G);
        tr_cvt(p.in[9], 1024, 2048, 0, 1024, WO0T, 0, T, bx, G);
        tr_cvt(p.in[12], 2304, 1024, 0, 2304, W1T, 0, T, bx, G);
        tr_cvt(p.in[14], 1024, 1024, 0, 1024, WO1T, 0, T, bx, G);
        for (int n = 0; n < 8; ++n) { tr_cvt(p.in[4] + n * 16384, 128, 128, 0, 128, WGT + n * 16384, 0, T, (bx + 32 * n) % G, G); tr_cvt(p.in[6] + n * 16384, 128, 128, 0, 128, WGT + (8 + n) * 16384, 0, T, (bx + 32 * n + 16) % G, G); }
        __syncthreads();
    }
    SEAM(0);
    if (IN(1)) {
        { pg8::Gemm g{XB, W0T, NTOK, 5120, 1024}; pg8::StaticOrder S; S.init(NTOK, 5120, G, bx); pg8::EpiBf16<0> E{H0, 5120, nullptr, 0, 0};
          pg8::gemm_phase<pg8::EpiBf16<0>, pg8::StaticOrder>(lds, g, S, E, nullptr); }
        { pg8::Gemm g{W0T + (size_t)5120 * 1024, XB, 1024, NTOK, 1024}; pg8::StaticOrder S; S.init(1024, NTOK, G, bx); pg8::EpiBf16<0> E{VT0, NTOK, nullptr, 0, 0};
          pg8::gemm_phase<pg8::EpiBf16<0>, pg8::StaticOrder>(lds, g, S, E, nullptr); }
    }
    SEAM(1);
    if (IN(2)) {
        for (int item = bx; item < 256; item += G) lru_item<1>(p, lds, item);
        for (int item = bx; item < 1024; item += G) sb_task(H0, VT0, Y0, item >> 8, (item >> 5) & 7, (item & 31) * 8 + wid, lane);
    }
    SEAM(2);
    if (IN(3)) { for (int item = bx; item < 256; item += G) lru_item<2>(p, lds, item); __syncthreads(); }
    SEAM(3);
    if (IN(4)) { pg8::Gemm g{Y0, WO0T, NTOK, 1024, 2048}; pg8::StaticOrder S; S.init(NTOK, 1024, G, bx); pg8::EpiResF32 E{X1, 1024, p.in[0], ALPHA};
        pg8::gemm_phase<pg8::EpiResF32, pg8::StaticOrder>(lds, g, S, E, nullptr); }
    SEAM(4);
    if (IN(5)) ln_phase(X1, X1, X1B, p.in[10], p.in[11], bx * 8 + wid, G * 8, lane);
    SEAM(5);
    if (IN(6)) {
        { pg8::Gemm g{X1B, W1T, NTOK, 2304, 1024}; pg8::StaticOrder S; S.init(NTOK, 2304, G, bx); pg8::EpiBf16<0> E{H1, 2304, nullptr, 0, 0};
          pg8::gemm_phase<pg8::EpiBf16<0>, pg8::StaticOrder>(lds, g, S, E, nullptr); }
        { pg8::Gemm g{W1T + (size_t)1024 * 1024, X1B, 256, NTOK, 1024}; pg8::StaticOrder S; S.init(256, NTOK, G, bx); pg8::EpiBf16<0> E{KVT1, NTOK, nullptr, 0, 0};
          pg8::gemm_phase<pg8::EpiBf16<0>, pg8::StaticOrder>(lds, g, S, E, nullptr); }
    }
    SEAM(6);
    if (IN(7)) { for (int item = bx; item < 2048; item += G) { const int qt = item & 255, c = (item >> 8) & 1, b = item >> 9; swa_task(H1, KVT1, p.in[13], Y1, b, c, c * 8 + wid, qt, lane); } }
    SEAM(7);
    if (IN(8)) { pg8::Gemm g{Y1, WO1T, NTOK, 1024, 1024}; pg8::StaticOrder S; S.init(NTOK, 1024, G, bx); pg8::EpiResF32 E{p.out, 1024, X1, ALPHA};
        pg8::gemm_phase<pg8::EpiResF32, pg8::StaticOrder>(lds, g, S, E, nullptr); }
    SEAM(8);
    if (IN(9)) ln_phase(p.out, p.out, nullptr, p.in[15], p.in[16], bx * 8 + wid, G * 8, lane);
#undef IN
#undef SEAM
}

#ifndef MK_MULTI
#define MK_MULTI 0
#endif
extern "C" void kernel_launch(void* const* d_in, const int* in_sizes, int n_in, void* d_out, int out_size, void* d_ws, size_t ws_size, hipStream_t stream) {
    static int grid = 0;
    if (grid == 0) {
        if (n_in != 17 || out_size != NTOK * DM || ws_size < WS_END) { fprintf(stderr, "kernel_launch: unexpected shapes (n_in %d, out %d, ws %zu)\n", n_in, out_size, ws_size); grid = -1; return; }
        int dev = 0, cus = 0, per_cu = 0;
        hipGetDevice(&dev); hipDeviceGetAttribute(&cus, hipDeviceAttributeMultiprocessorCount, dev);
        if (hipFuncSetAttribute((const void*)mk_fwd, hipFuncAttributeMaxDynamicSharedMemorySize, LDS_BYTES) != hipSuccess) { fprintf(stderr, "kernel_launch: hipFuncSetAttribute failed\n"); grid = -1; return; }
        hipOccupancyMaxActiveBlocksPerMultiprocessor(&per_cu, (const void*)mk_fwd, 512, LDS_BYTES);
        (void)hipGetLastError();
        if (per_cu < 1) per_cu = 1;
        grid = cus;
    }
    if (grid < 0) return;
    Params p{};
    for (int i = 0; i < 17; ++i) p.in[i] = (const float*)d_in[i];
    p.out = (float*)d_out; p.ws = (unsigned char*)d_ws;
#if MK_MULTI
    for (int ph = 0; ph < N_PHASES; ++ph) { p.ph_lo = ph; p.ph_hi = ph + 1; hipLaunchKernelGGL(mk_fwd, dim3(grid), dim3(512), LDS_BYTES, stream, p); }
#else
    p.ph_lo = 0; p.ph_hi = N_PHASES;
    void* args[] = {&p};
    hipError_t e = hipLaunchCooperativeKernel((const void*)mk_fwd, dim3(grid), dim3(512), args, LDS_BYTES, stream);
    if (e != hipSuccess) fprintf(stderr, "cooperative launch failed: %s (grid %d)\n", hipGetErrorString(e), grid);
#endif
}
```

```cpp
#include <hip/hip_runtime.h>
#include <hip/hip_cooperative_groups.h>
#include <cstdio>
namespace cg = cooperative_groups;
#ifndef PROBE_DUP
#define PROBE_DUP -1
#endif
namespace pg8 {
#define PG8_LAS __attribute__((address_space(3)))
typedef unsigned short bf16_t;
typedef short bf16x8 __attribute__((ext_vector_type(8)));
typedef float f32x4 __attribute__((ext_vector_type(4)));
typedef unsigned u32x4 __attribute__((ext_vector_type(4)));
constexpr int BM = 256, BK = 64, HALF = 128, HTB = HALF * BK * 2  , STAGE_BYTES = 8 * HTB, NXCD = 8, WGM = 8;

__host__ __device__ __forceinline__ int lds_byte(int r, int c) { const int st = (r >> 4) * 2 + (c >> 5), rr = r & 15, cc = c & 31, ob = rr * 64 + cc * 2; return st * 1024 + (ob ^ (((ob >> 9) & 1) << 5)); }
__host__ __device__ __forceinline__ void stage_rc(int b, int& R, int& C) { const int st = b / 1024, sb = b % 1024, swz = sb ^ (((sb >> 9) & 1) << 5); R = (st >> 1) * 16 + swz / 64; C = (st & 1) * 32 + (swz % 64) / 2; }
__host__ __device__ __forceinline__ int perm32(int rho) { const int n = rho >> 4, i = rho & 15; return 8 * (i >> 2) + 4 * n + (i & 3); }

struct Unit { int pm, pn; };
struct Gemm { const bf16_t* A; const bf16_t* Bt; int M, N, K; };

struct StaticOrder {
    int nM, nN, nwg, G, c;
    __host__ __device__ void init(int M, int N, int G_, int c_) { nM = M / BM; nN = N / BM; nwg = nM * nN; G = G_; c = c_; }
    __host__ __device__ bool next(int i, Unit& u) const {
        const long L = (long)i * G + c; if (L >= nwg) return false;
        int wgid = (int)L; { const int q = nwg / NXCD, r = nwg % NXCD, xcd = wgid % NXCD, off = wgid / NXCD; wgid = (xcd < r ? xcd * (q + 1) : r * (q + 1) + (xcd - r) * q) + off; }
        const int nig = WGM * nN, gid = wgid / nig, fm = gid * WGM, gsz = (nM - fm) < WGM ? (nM - fm) : WGM;
        u.pm = fm + ((wgid % nig) % gsz); u.pn = (wgid % nig) / gsz; return true;
    }
    __device__ __forceinline__ void a_ready(const Unit&) const {}
    __device__ __forceinline__ void done(const Unit&) const {}
};

__device__ __forceinline__ unsigned cvt_pk_bf16(float lo, float hi) { unsigned r; asm volatile("v_cvt_pk_bf16_f32 %0, %1, %2" : "=v"(r) : "v"(lo), "v"(hi)); return r; }
typedef float f32x2 __attribute__((ext_vector_type(2)));
struct EpiF32 {
    static constexpr bool PERM = false, AFTER_DRAIN = false;
    float* C; int ldc; const float* bias;
    __device__ __forceinline__ void operator()(const f32x4 (&acc)[2][2][4][2], const Unit& u, int wr, int wc, int fr, int fq) const {
        const int row0 = u.pm * BM + wr * 64 + fr, col0 = u.pn * BM + wc * 32 + 4 * fq;
        f32x4 bv[2][2];
#pragma unroll
        for (int bj = 0; bj < 2; ++bj)
#pragma unroll
            for (int n = 0; n < 2; ++n) bv[bj][n] = bias ? *(const f32x4*)(bias + col0 + bj * HALF + n * 16) : (f32x4){0.f, 0.f, 0.f, 0.f};
#pragma unroll
        for (int ai = 0; ai < 2; ++ai)
#pragma unroll
            for (int m = 0; m < 4; ++m) { float* rowp = C + (size_t)(row0 + ai * HALF + m * 16) * ldc + col0;
#pragma unroll
                for (int bj = 0; bj < 2; ++bj)
#pragma unroll
                    for (int n = 0; n < 2; ++n) *(f32x4*)(rowp + bj * HALF + n * 16) = acc[ai][bj][m][n] + bv[bj][n]; }
    }
};
struct EpiResF32 {
    static constexpr bool PERM = false, AFTER_DRAIN = false;
    float* C; int ldc; const float* R; float alpha;
    __device__ __forceinline__ void operator()(const f32x4 (&acc)[2][2][4][2], const Unit& u, int wr, int wc, int fr, int fq) const {
        const int row0 = u.pm * BM + wr * 64 + fr, col0 = u.pn * BM + wc * 32 + 4 * fq;
#pragma unroll
        for (int ai = 0; ai < 2; ++ai)
#pragma unroll
            for (int m = 0; m < 4; ++m) { const size_t off = (size_t)(row0 + ai * HALF + m * 16) * ldc + col0;
#pragma unroll
                for (int bj = 0; bj < 2; ++bj)
#pragma unroll
                    for (int n = 0; n < 2; ++n) { const f32x4 rv = *(const f32x4*)(R + off + bj * HALF + n * 16); *(f32x4*)(C + off + bj * HALF + n * 16) = acc[ai][bj][m][n] + rv * alpha; } }
    }
};
template <int ACT  > struct EpiBf16 {
    static constexpr bool PERM = true, AFTER_DRAIN = false;
    bf16_t* O; int ldc; const float* bias; int split_cols; size_t split_stride;
    __device__ __forceinline__ void operator()(const f32x4 (&acc)[2][2][4][2], const Unit& u, int wr, int wc, int fr, int fq) const {
        const int row0 = u.pm * BM + wr * 64 + fr; int colt = u.pn * BM; bf16_t* base = O;
        if (split_cols) { const int t = colt / split_cols; base += (size_t)t * split_stride; colt -= t * split_cols; }
        const int col0 = colt + wc * 32 + 8 * fq, bcol0 = u.pn * BM + wc * 32 + 8 * fq;
        f32x4 bv[2][2];
#pragma unroll
        for (int bj = 0; bj < 2; ++bj)
#pragma unroll
            for (int n = 0; n < 2; ++n) bv[bj][n] = bias ? *(const f32x4*)(bias + bcol0 + bj * HALF + 4 * n) : (f32x4){0.f, 0.f, 0.f, 0.f};
#pragma unroll
        for (int ai = 0; ai < 2; ++ai)
#pragma unroll
            for (int m = 0; m < 4; ++m) { bf16_t* rowp = base + (size_t)(row0 + ai * HALF + m * 16) * ldc + col0;
#pragma unroll
                for (int bj = 0; bj < 2; ++bj) { f32x4 v0 = acc[ai][bj][m][0] + bv[bj][0], v1 = acc[ai][bj][m][1] + bv[bj][1];
                    u32x4 w; w.x = cvt_pk_bf16(v0[0], v0[1]); w.y = cvt_pk_bf16(v0[2], v0[3]); w.z = cvt_pk_bf16(v1[0], v1[1]); w.w = cvt_pk_bf16(v1[2], v1[3]);
                    *(u32x4*)(rowp + bj * HALF) = w; } }
    }
};
template <class Epi, class Sched, bool STAMP = false>
__device__ __forceinline__ void gemm_phase(PG8_LAS unsigned char* lds, const Gemm g, const Sched& S, const Epi& E, unsigned long long* stamps) {
    const int tid = threadIdx.x, wid = __builtin_amdgcn_readfirstlane(tid >> 6), lane = tid & 63, wr = wid >> 2, wc = wid & 3, fr = lane & 15, fq = lane >> 4;
    const int K = g.K, nt = K / BK;
    int ts_lo = 0, ts_hi = 0, nts = 0; const unsigned long long rt_entry = STAMP ? (unsigned long long)wall_clock64() : 0ull;
#define PG8_STAMP() do { if (STAMP && wid == 0 && nts < 64) { const unsigned long long _c = (unsigned long long)clock64(); \
        ts_lo = (lane == nts) ? (int)(unsigned)_c : ts_lo; ts_hi = (lane == nts) ? (int)(unsigned)(_c >> 32) : ts_hi; ++nts; } } while (0)
    PG8_STAMP();
    unsigned voffA[2], voffB[2];
#pragma unroll
    for (int i = 0; i < 2; ++i) { int R, C; stage_rc(tid * 16 + i * 8192, R, C); const int Rb = Epi::PERM ? ((R & ~31) + perm32(R & 31)) : R;
        voffA[i] = (unsigned)(R * K + C) * 2u; voffB[i] = (unsigned)(Rb * K + C) * 2u; }
    const size_t kstep = (size_t)(BK * 2);
    const size_t hstep = (size_t)HALF * K * 2;
    const size_t tstep = 2 * hstep;
    const unsigned ldsw = (unsigned)wid * 1024u;
    const int aoff = lds_byte(wr * 64 + fr, fq * 8), boff = lds_byte(wc * 32 + fr, fq * 8);
#define PG8_SA(b, h) (((b) * 2 + (h)) * HTB)
#define PG8_SB(b, h) ((4 + (b) * 2 + (h)) * HTB)
#define PG8_STAGE(bufoff, gbase, voff) do { _Pragma("unroll") for (int _i = 0; _i < 2; ++_i) \
        __builtin_amdgcn_global_load_lds((const unsigned*)((const char*)(gbase) + (voff)[_i]), (PG8_LAS unsigned*)(lds + (bufoff) + ldsw + _i * 8192), 16, 0, 0); } while (0)
#define PG8_LDA(dst, b, h) do { _Pragma("unroll") for (int m = 0; m < 4; ++m) _Pragma("unroll") for (int k = 0; k < 2; ++k) dst[m][k] = *(const PG8_LAS bf16x8*)(lds + PG8_SA(b, h) + aoff + m * 2048 + k * 1024); } while (0)
#define PG8_LDB(dst, b, h) do { _Pragma("unroll") for (int n = 0; n < 2; ++n) _Pragma("unroll") for (int k = 0; k < 2; ++k) dst[n][k] = *(const PG8_LAS bf16x8*)(lds + PG8_SB(b, h) + boff + n * 2048 + k * 1024); } while (0)
#define PG8_MMA(ai, bj, At, Bt) do { __builtin_amdgcn_s_setprio(1); _Pragma("unroll") for (int m = 0; m < 4; ++m) _Pragma("unroll") for (int n = 0; n < 2; ++n) _Pragma("unroll") for (int k = 0; k < 2; ++k) \
        acc[ai][bj][m][n] = __builtin_amdgcn_mfma_f32_16x16x32_bf16(Bt[n][k], At[m][k], acc[ai][bj][m][n], 0, 0, 0); __builtin_amdgcn_s_setprio(0); } while (0)
#define PG8_WAIT_V(n) asm volatile("s_waitcnt vmcnt(" #n ")" ::: "memory")
#define PG8_WAIT_L(n) asm volatile("s_waitcnt lgkmcnt(" #n ")" ::: "memory")
#define PG8_BAR __builtin_amdgcn_s_barrier()
#define PG8_SCHED __builtin_amdgcn_sched_barrier(0)
    Unit cur, nxt; int ui = 0;
    if (!S.next(0, cur)) return;
    f32x4 acc[2][2][4][2];
#pragma unroll
    for (int a = 0; a < 2; ++a)
#pragma unroll
        for (int b = 0; b < 2; ++b)
#pragma unroll
            for (int m = 0; m < 4; ++m)
#pragma unroll
                for (int n = 0; n < 2; ++n) acc[a][b][m][n] = (f32x4){0.f, 0.f, 0.f, 0.f};
    bf16x8 At[4][2], B0[2][2], B1[2][2];
    const char* cA = (const char*)g.A + (size_t)cur.pm * tstep; const char* cB = (const char*)g.Bt + (size_t)cur.pn * tstep;
    S.a_ready(cur);
    PG8_STAGE(PG8_SB(0, 0), cB, voffB); PG8_STAGE(PG8_SA(0, 0), cA, voffA); PG8_STAGE(PG8_SB(0, 1), cB + hstep, voffB); PG8_STAGE(PG8_SA(0, 1), cA + hstep, voffA);
    if (wr == 1) PG8_BAR;
    PG8_WAIT_V(4); PG8_BAR;
    PG8_STAGE(PG8_SB(1, 0), cB + kstep, voffB); PG8_STAGE(PG8_SA(1, 0), cA + kstep, voffA); PG8_STAGE(PG8_SB(1, 1), cB + hstep + kstep, voffB);
    PG8_WAIT_V(6); PG8_BAR;
    PG8_STAMP();
    for (;;) {
        const bool has_next = S.next(ui + 1, nxt);
        const char* nA = has_next ? (const char*)g.A + (size_t)nxt.pm * tstep : cA; const char* nB = has_next ? (const char*)g.Bt + (size_t)nxt.pn * tstep : cB;
        for (int t = 0; t < nt; t += 2) {
            const bool last = (t == nt - 2);
            const char* a1 = cA + (size_t)(t + 1) * kstep;
            const char* a2 = last ? nA : cA + (size_t)(t + 2) * kstep; const char* b2 = last ? nB : cB + (size_t)(t + 2) * kstep;
            const char* a3 = a2 + kstep; const char* b3 = b2 + kstep;
            if (last && has_next) S.a_ready(nxt);
            PG8_LDB(B0, 0, 0); PG8_SCHED; PG8_LDA(At, 0, 0); PG8_STAGE(PG8_SA(1, 1), a1 + hstep, voffA);
            PG8_WAIT_L(8); PG8_BAR; PG8_WAIT_L(0); PG8_MMA(0, 0, At, B0); PG8_BAR; PG8_SCHED;
            PG8_LDB(B1, 0, 1); PG8_STAGE(PG8_SB(0, 0), b2, voffB);
            PG8_BAR; PG8_WAIT_L(0); PG8_MMA(0, 1, At, B1); PG8_BAR;
            PG8_LDA(At, 0, 1); PG8_STAGE(PG8_SA(0, 0), a2, voffA);
            PG8_BAR; PG8_WAIT_L(0); PG8_MMA(1, 0, At, B0); PG8_BAR; PG8_SCHED;
            PG8_STAGE(PG8_SB(0, 1), b2 + hstep, voffB);
            PG8_WAIT_V(6); PG8_BAR; PG8_MMA(1, 1, At, B1); PG8_BAR;
            PG8_LDB(B0, 1, 0); PG8_SCHED; PG8_LDA(At, 1, 0); PG8_STAGE(PG8_SA(0, 1), a2 + hstep, voffA);
            PG8_WAIT_L(8); PG8_BAR; PG8_WAIT_L(0); PG8_MMA(0, 0, At, B0); PG8_BAR; PG8_SCHED;
            PG8_LDB(B1, 1, 1); PG8_STAGE(PG8_SB(1, 0), b3, voffB);
            PG8_BAR; PG8_WAIT_L(0); PG8_MMA(0, 1, At, B1); PG8_BAR;
            PG8_LDA(At, 1, 1); PG8_STAGE(PG8_SA(1, 0), a3, voffA);
            PG8_BAR; PG8_WAIT_L(0); PG8_MMA(1, 0, At, B0); PG8_BAR; PG8_SCHED;
            PG8_STAGE(PG8_SB(1, 1), b3 + hstep, voffB);
            PG8_WAIT_V(6); PG8_BAR; PG8_MMA(1, 1, At, B1); PG8_BAR;
        }
        PG8_STAMP();
        if constexpr (!Epi::AFTER_DRAIN) { E(acc, cur, wr, wc, fr, fq); S.done(cur); }
        PG8_STAMP();
        if (!has_next) break;
#pragma unroll
        for (int a = 0; a < 2; ++a)
#pragma unroll
            for (int b = 0; b < 2; ++b)
#pragma unroll
                for (int m = 0; m < 4; ++m)
#pragma unroll
                    for (int n = 0; n < 2; ++n) acc[a][b][m][n] = (f32x4){0.f, 0.f, 0.f, 0.f};
        cur = nxt; cA = nA; cB = nB; ++ui;
    }
    PG8_WAIT_V(0);
    if (wr == 0) PG8_BAR;
    PG8_BAR;
    if constexpr (Epi::AFTER_DRAIN) { E.fused(acc, cur, wr, wc, fr, fq, lds, wid, lane); S.done(cur); }
    PG8_STAMP();
    if (STAMP && wid == 0) { stamps[lane] = lane < nts ? (((unsigned long long)(unsigned)ts_hi << 32) | (unsigned)ts_lo) : 0ull;
        if (lane == 62) stamps[62] = rt_entry; if (lane == 63) stamps[63] = (unsigned long long)wall_clock64(); }
#undef PG8_STAMP
#undef PG8_SA
#undef PG8_SB
#undef PG8_STAGE
#undef PG8_LDA
#undef PG8_LDB
#undef PG8_MMA
#undef PG8_WAIT_V
#undef PG8_WAIT_L
#undef PG8_BAR
#undef PG8_SCHED
}
}

#define LAS __attribute__((address_space(3)))
typedef unsigned short bf16_t;
typedef short bf16x8 __attribute__((ext_vector_type(8)));
typedef float f32x4 __attribute__((ext_vector_type(4)));
typedef float f32x2 __attribute__((ext_vector_type(2)));
typedef float f32x16 __attribute__((ext_vector_type(16)));
typedef unsigned u32x4 __attribute__((ext_vector_type(4)));
typedef unsigned u32x2 __attribute__((ext_vector_type(2)));

constexpr int NTOK = 32768, SEQ = 8192, DM = 1024;
constexpr int H0W = 5184;
constexpr int VTP = NTOK + 2112;
constexpr int H0N = 5120;
constexpr int H1W = 2368;
constexpr int H1N = 2304;
constexpr float ALPHA = 1.4142135623730951f;
constexpr float LN_EPS = 1e-5f;
constexpr size_t MiB = 1ull << 20;
constexpr size_t WS_W0T = 0;
constexpr size_t WS_WO0T = 12 * MiB;
constexpr size_t WS_W1T = 16 * MiB;
constexpr size_t WS_WO1T = 21 * MiB;
constexpr size_t WS_WGT = 23 * MiB;
constexpr size_t WS_SUM = 24 * MiB;
constexpr size_t WS_BAR = 25 * MiB;
constexpr size_t WS_XB = 32 * MiB;
constexpr size_t WS_VT0 = 96 * MiB;
constexpr size_t WS_H0 = 165 * MiB;
constexpr size_t WS_END = 489 * MiB;

struct Params { const float* in[17]; float* out; unsigned char* ws; int ph_lo, ph_hi; };

__device__ __forceinline__ unsigned pk2(float lo, float hi) { return pg8::cvt_pk_bf16(lo, hi); }
__device__ __forceinline__ float bflo(unsigned v) { return __uint_as_float(v << 16); }
__device__ __forceinline__ float bfhi(unsigned v) { return __uint_as_float(v & 0xffff0000u); }
__device__ __forceinline__ float fsigmoid(float x) { return __builtin_amdgcn_rcpf(1.0f + __expf(-x)); }
__device__ __forceinline__ float fsilu(float x) { return x * fsigmoid(x); }
__device__ __forceinline__ float wave_sum(float v) {
#pragma unroll
    for (int o = 32; o >= 1; o >>= 1) v += __shfl_xor(v, o);
    return v; }
__device__ __forceinline__ int pi32(int r) { return (r & 0x13) | ((r & 4) << 1) | ((r & 8) >> 1); }
#define MFMA32(a, b, c) __builtin_amdgcn_mfma_f32_32x32x16_bf16((a), (b), (c), 0, 0, 0)

__device__ __forceinline__ void cvt_x(const float* __restrict__ x, bf16_t* __restrict__ xb, size_t gtid, size_t gthreads) {
    for (size_t i = gtid; i < (size_t)NTOK * DM / 8; i += gthreads) {
        const f32x4 a = *(const f32x4*)(x + i * 8), b = *(const f32x4*)(x + i * 8 + 4);
        u32x4 w; w.x = pk2(a[0], a[1]); w.y = pk2(a[2], a[3]); w.z = pk2(b[0], b[1]); w.w = pk2(b[2], b[3]);
        *(u32x4*)(xb + i * 8) = w; }
}
__device__ __forceinline__ void tr_cvt(const float* __restrict__ src, int ld, int K, int scol0, int ncols, bf16_t* __restrict__ dst, int drow0, LAS float* T, int blk, int nblk) {
    const int tid = threadIdx.x, tk = K / 64, tn = ncols / 64;
    for (int t = blk; t < tk * tn; t += nblk) {
        const int k0 = (t % tk) * 64, n0 = (t / tk) * 64;
        __syncthreads();
#pragma unroll
        for (int i = 0; i < 2; ++i) { const int kr = (tid >> 4) + 32 * i, c4 = (tid & 15) * 4;
            const f32x4 v = *(const f32x4*)(src + (size_t)(k0 + kr) * ld + scol0 + n0 + c4);
            T[kr * 65 + c4] = v[0]; T[kr * 65 + c4 + 1] = v[1]; T[kr * 65 + c4 + 2] = v[2]; T[kr * 65 + c4 + 3] = v[3]; }
        __syncthreads();
        { const int n = tid >> 3, k8 = (tid & 7) * 8; float v[8];
#pragma unroll
            for (int j = 0; j < 8; ++j) v[j] = T[(k8 + j) * 65 + n];
            u32x4 w; w.x = pk2(v[0], v[1]); w.y = pk2(v[2], v[3]); w.z = pk2(v[4], v[5]); w.w = pk2(v[6], v[7]);
            *(u32x4*)(dst + (size_t)(drow0 + n0 + n) * K + k0 + k8) = w; }
    }
}

__device__ __forceinline__ void ln_phase(const float* z, float* of, bf16_t* ob, const float* __restrict__ g, const float* __restrict__ bta, int gwave, int ngwaves, int lane) {
    f32x4 gv[4], bv[4];
#pragma unroll
    for (int i = 0; i < 4; ++i) { gv[i] = *(const f32x4*)(g + i * 256 + lane * 4); bv[i] = *(const f32x4*)(bta + i * 256 + lane * 4); }
    for (int row = gwave; row < NTOK; row += ngwaves) {
        const float* zr = z + (size_t)row * DM; f32x4 v[4];
#pragma unroll
        for (int i = 0; i < 4; ++i) v[i] = *(const f32x4*)(zr + i * 256 + lane * 4);
        float s = 0.f;
#pragma unroll
        for (int i = 0; i < 4; ++i) s += (v[i][0] + v[i][1]) + (v[i][2] + v[i][3]);
        const float mean = wave_sum(s) * (1.0f / 1024.0f);
        float q = 0.f;
#pragma unroll
        for (int i = 0; i < 4; ++i) { const f32x4 d = v[i] - mean; q += (d[0] * d[0] + d[1] * d[1]) + (d[2] * d[2] + d[3] * d[3]); }
        const float rstd = rsqrtf(wave_sum(q) * (1.0f / 1024.0f) + LN_EPS);
#pragma unroll
        for (int i = 0; i < 4; ++i) { const f32x4 y = (v[i] - mean) * rstd * gv[i] + bv[i];
            *(f32x4*)(of + (size_t)row * DM + i * 256 + lane * 4) = y;
            if (ob) { u32x2 w; w.x = pk2(y[0], y[1]); w.y = pk2(y[2], y[3]); *(u32x2*)(ob + (size_t)row * DM + i * 256 + lane * 4) = w; } }
    }
}

__device__ __forceinline__ void sb_task(const bf16_t* __restrict__ H0, const bf16_t* __restrict__ VT, bf16_t* __restrict__ Y0, int b, int h, int qt, int lane) {
    const int r = lane & 31, hh = lane >> 5, pr = pi32(r), q0 = qt * 32;
    const size_t tb = (size_t)b * SEQ;
    const float SCALE = 0.08838834764831845f;
    bf16x8 qf[8];
    { const bf16_t* qrow = H0 + (tb + q0 + r) * H0W + 2048 + h * 128 + 8 * hh;
#pragma unroll
      for (int s = 0; s < 8; ++s) qf[s] = *(const bf16x8*)(qrow + 16 * s); }
    bf16x8 uf[2];
#pragma unroll
    for (int s = 0; s < 2; ++s)
#pragma unroll
        for (int j = 0; j < 8; ++j) uf[s][j] = (16 * s + 8 * hh + j > pr) ? (short)0x3F80 : (short)0;
    f32x16 o[4];
#pragma unroll
    for (int dt = 0; dt < 4; ++dt)
#pragma unroll
        for (int i = 0; i < 16; ++i) o[dt][i] = 0.f;
    float carry = 0.f;
    const bf16_t* vbase = VT + (size_t)(h * 128 + r) * VTP + tb + 8 * hh;
    const bf16_t* kbase = H0 + (tb + pr) * H0W + 3072 + h * 128 + 8 * hh;
    bf16x8 kn[8];
#pragma unroll
    for (int s = 0; s < 8; ++s) kn[s] = *(const bf16x8*)(kbase + (size_t)(qt * 32) * H0W + 16 * s);
    for (int kb = qt; kb >= 0; --kb) {
        const int k0 = kb * 32;
        bf16x8 kf[8];
#pragma unroll
        for (int s = 0; s < 8; ++s) kf[s] = kn[s];
        { const int kp = kb > 0 ? k0 - 32 : 0;
#pragma unroll
          for (int s = 0; s < 8; ++s) kn[s] = *(const bf16x8*)(kbase + (size_t)kp * H0W + 16 * s); }
        f32x16 st;
#pragma unroll
        for (int i = 0; i < 16; ++i) st[i] = 0.f;
#pragma unroll
        for (int s = 0; s < 8; ++s) st = MFMA32(kf[s], qf[s], st);
        bf16x8 vf[4][2];
#pragma unroll
        for (int dt = 0; dt < 4; ++dt)
#pragma unroll
            for (int s = 0; s < 2; ++s) vf[dt][s] = *(const bf16x8*)(vbase + (size_t)(32 * dt) * VTP + k0 + 16 * s);
        const bool diag = (kb == qt);
        float L[16], lb[16]; float psum = 0.f;
#pragma unroll
        for (int i = 0; i < 16; ++i) {
            const float z = st[i] * SCALE;
            const float sp = fmaxf(z, 0.f) + __logf(1.0f + __expf(-fabsf(z)));
            const int key = 16 * (i >> 3) + 8 * hh + (i & 7);
            const bool valid = !diag || (key < r);
            L[i] = valid ? -sp : 0.f; lb[i] = valid ? (z - sp) : -1e30f; psum += L[i]; }
        const float tot = psum + __shfl_xor(psum, 32);
        union { bf16x8 v; unsigned u[4]; } hi[2], lo[2], pf[2];
#pragma unroll
        for (int s = 0; s < 2; ++s)
#pragma unroll
            for (int jj = 0; jj < 4; ++jj) { const float a0 = L[8 * s + 2 * jj], a1 = L[8 * s + 2 * jj + 1];
                const unsigned ph = pk2(a0, a1); hi[s].u[jj] = ph; lo[s].u[jj] = pk2(a0 - bflo(ph), a1 - bfhi(ph)); }
        f32x16 suf;
#pragma unroll
        for (int i = 0; i < 16; ++i) suf[i] = 0.f;
#pragma unroll
        for (int s = 0; s < 2; ++s) { suf = MFMA32(uf[s], hi[s].v, suf); suf = MFMA32(uf[s], lo[s].v, suf); }
        float w[16];
#pragma unroll
        for (int i = 0; i < 16; ++i) w[i] = __expf(lb[i] + suf[i] + carry);
        carry += tot;
#pragma unroll
        for (int s = 0; s < 2; ++s)
#pragma unroll
            for (int jj = 0; jj < 4; ++jj) pf[s].u[jj] = pk2(w[8 * s + 2 * jj], w[8 * s + 2 * jj + 1]);
#pragma unroll
        for (int dt = 0; dt < 4; ++dt)
#pragma unroll
            for (int s = 0; s < 2; ++s) o[dt] = MFMA32(vf[dt][s], pf[s].v, o[dt]);
        if (__all(carry < -110.0f)) break;
    }
    const size_t tok = tb + q0 + r;
#pragma unroll
    for (int dt = 0; dt < 4; ++dt)
#pragma unroll
        for (int g4 = 0; g4 < 4; ++g4) { const int d0 = 32 * dt + 8 * g4 + 4 * hh;
            const u32x2 gv = *(const u32x2*)(H0 + tok * H0W + 4096 + h * 128 + d0);
            const float y0 = o[dt][4 * g4] * fsilu(bflo(gv.x)), y1 = o[dt][4 * g4 + 1] * fsilu(bfhi(gv.x)), y2 = o[dt][4 * g4 + 2] * fsilu(bflo(gv.y)), y3 = o[dt][4 * g4 + 3] * fsilu(bfhi(gv.y));
            u32x2 wv; wv.x = pk2(y0, y1); wv.y = pk2(y2, y3);
            *(u32x2*)(Y0 + tok * 2048 + 1024 + h * 128 + d0) = wv; }
}

typedef short s16x4 __attribute__((ext_vector_type(4)));
constexpr int SWA_K = 0, SWA_V = 23040, SWA_Q = 53760, SWA_G = 87040;
constexpr int SWA_KP = 144, SWA_VP = 192, SWA_QP = 1040;
__device__ __forceinline__ void swa_item(const bf16_t* __restrict__ H1, const float* __restrict__ sinks, bf16_t* __restrict__ Y1, LAS unsigned char* lds, int b, int c, int qt) {
    const int tid = threadIdx.x, lane = tid & 63, wid = tid >> 6;
    const int r = lane & 31, hh = lane >> 5, pr = pi32(r), q0 = qt * 32, hc = c * 8 + wid;
    const size_t tb = (size_t)b * SEQ;
    const float slope = exp2f(-0.5f * (float)(hc + 1)), sink = sinks[hc];
    __syncthreads();
#pragma unroll
    for (int i = 0; i < 3; ++i) { const int idx = tid + 512 * i;
        if (idx < 1280) { const int row = idx >> 3, ch = idx & 7, t = q0 - 128 + row; u32x4 kv = (u32x4){0u, 0u, 0u, 0u}, vv = (u32x4){0u, 0u, 0u, 0u};
            if (t >= 0) { const bf16_t* src = H1 + (tb + t) * H1W + 1024 + c * 64 + ch * 8; kv = *(const u32x4*)src; vv = *(const u32x4*)(src + 128); }
            *(LAS u32x4*)(lds + SWA_K + row * SWA_KP + ch * 16) = kv; *(LAS u32x4*)(lds + SWA_V + row * SWA_VP + ch * 16) = vv; } }
#pragma unroll
    for (int i = 0; i < 4; ++i) { const int idx = tid + 512 * i, row = idx >> 6, ch = idx & 63; const bf16_t* src = H1 + (tb + q0 + row) * H1W + c * 512 + ch * 8;
        const u32x4 qv = *(const u32x4*)src, gq = *(const u32x4*)(src + 1280);
        *(LAS u32x4*)(lds + SWA_Q + row * SWA_QP + ch * 16) = qv; *(LAS u32x4*)(lds + SWA_G + row * SWA_QP + ch * 16) = gq; }
    __syncthreads();
    bf16x8 qf[4];
#pragma unroll
    for (int s = 0; s < 4; ++s) qf[s] = *(const LAS bf16x8*)(lds + SWA_Q + r * SWA_QP + wid * 128 + 32 * s + 16 * hh);
    __syncthreads();
    f32x16 o[2];
#pragma unroll
    for (int dt = 0; dt < 2; ++dt)
#pragma unroll
        for (int i = 0; i < 16; ++i) o[dt][i] = 0.f;
    float m = sink, l = 1.0f;
    const int vlane = 32 * ((lane >> 4) & 1) + 8 * (lane & 3) + SWA_VP * (8 * hh + ((lane & 15) >> 2));
#pragma unroll 1
    for (int j = 0; j < 5; ++j) {
        f32x16 st;
#pragma unroll
        for (int i = 0; i < 16; ++i) st[i] = 0.f;
#pragma unroll
        for (int s = 0; s < 4; ++s) { const bf16x8 kf = *(const LAS bf16x8*)(lds + SWA_K + (32 * j + pr) * SWA_KP + 32 * s + 16 * hh); st = MFMA32(kf, qf[s], st); }
        union { bf16x8 v; s16x4 h[2]; } vf[2][2];
#pragma unroll
        for (int dt = 0; dt < 2; ++dt)
#pragma unroll
            for (int s = 0; s < 2; ++s)
#pragma unroll
                for (int t = 0; t < 2; ++t) vf[dt][s].h[t] = __builtin_amdgcn_ds_read_tr16_b64_v4i16((LAS s16x4*)(lds + SWA_V + (32 * j + 16 * s + 4 * t) * SWA_VP + 64 * dt + vlane));
        float bmax = -1e30f;
#pragma unroll
        for (int i = 0; i < 16; ++i) { const int dist = r - (32 * (j - 4) + 16 * (i >> 3) + 8 * hh + (i & 7));
            const bool valid = dist >= 0 && dist < 128 && dist <= q0 + r;
            st[i] = valid ? (st[i] * 0.125f - slope * (float)dist) : -1e30f; bmax = fmaxf(bmax, st[i]); }
        bmax = fmaxf(bmax, __shfl_xor(bmax, 32));
        const float mn = fmaxf(m, bmax), al = __expf(m - mn);
        float psum = 0.f;
#pragma unroll
        for (int i = 0; i < 16; ++i) { st[i] = __expf(st[i] - mn); psum += st[i]; }
        psum += __shfl_xor(psum, 32);
        l = l * al + psum; m = mn;
#pragma unroll
        for (int dt = 0; dt < 2; ++dt)
#pragma unroll
            for (int i = 0; i < 16; ++i) o[dt][i] *= al;
        union { bf16x8 v; unsigned u[4]; } pf[2];
#pragma unroll
        for (int s = 0; s < 2; ++s)
#pragma unroll
            for (int jj = 0; jj < 4; ++jj) pf[s].u[jj] = pk2(st[8 * s + 2 * jj], st[8 * s + 2 * jj + 1]);
#pragma unroll
        for (int dt = 0; dt < 2; ++dt)
#pragma unroll
            for (int s = 0; s < 2; ++s) o[dt] = MFMA32(vf[dt][s].v, pf[s].v, o[dt]);
    }
    const float inv = __builtin_amdgcn_rcpf(l);
#pragma unroll
    for (int dt = 0; dt < 2; ++dt)
#pragma unroll
        for (int g4 = 0; g4 < 4; ++g4) { const int boff = r * SWA_QP + wid * 128 + (32 * dt + 8 * g4 + 4 * hh) * 2; const u32x2 g = *(const LAS u32x2*)(lds + SWA_G + boff);
            const float y0 = o[dt][4 * g4] * inv * fsilu(bflo(g.x)), y1 = o[dt][4 * g4 + 1] * inv * fsilu(bfhi(g.x)), y2 = o[dt][4 * g4 + 2] * inv * fsilu(bflo(g.y)), y3 = o[dt][4 * g4 + 3] * inv * fsilu(bfhi(g.y));
            u32x2 wv; wv.x = pk2(y0, y1); wv.y = pk2(y2, y3);
            *(LAS u32x2*)(lds + SWA_Q + boff) = wv; }
    __syncthreads();
#pragma unroll
    for (int i = 0; i < 4; ++i) { const int idx = tid + 512 * i, row = idx >> 6, ch = idx & 63;
        *(u32x4*)(Y1 + (tb + q0 + row) * 1024 + c * 512 + ch * 8) = *(const LAS u32x4*)(lds + SWA_Q + row * SWA_QP + ch * 16); }
}

constexpr int LRU_XCB = 0, LRU_XCF = 17408, LRU_AF = LRU_XCF + 32768, LRU_UF = LRU_AF + 32768;
template <int PASS>
__device__ __forceinline__ void lru_item(const Params& p, LAS unsigned char* lds, int item) {
    const int tid = threadIdx.x, lane = tid & 63, wid = tid >> 6;
    const int pair = item & 31, seg = item >> 5, b = pair >> 3, n = pair & 7;
    const size_t tb = (size_t)b * SEQ;
    const bf16_t* H0 = (const bf16_t*)(p.ws + WS_H0); const bf16_t* WGT = (const bf16_t*)(p.ws + WS_WGT);
    f32x2* SUM = (f32x2*)(p.ws + WS_SUM); bf16_t* Y0 = (bf16_t*)p.out;
    LAS bf16_t* XCB = (LAS bf16_t*)(lds + LRU_XCB); LAS float* XCF = (LAS float*)(lds + LRU_XCF); LAS float* AF = (LAS float*)(lds + LRU_AF); LAS float* UF = (LAS float*)(lds + LRU_UF);
    const int r = lane & 31, hh = lane >> 5, ct = wid & 3, tt = wid >> 2;
    bf16x8 wa[8], wx[8];
    { const bf16_t* wga = WGT + ((size_t)(n) * 128 + 32 * ct + r) * 128 + 8 * hh; const bf16_t* wgx = WGT + ((size_t)(8 + n) * 128 + 32 * ct + r) * 128 + 8 * hh;
#pragma unroll
      for (int s = 0; s < 8; ++s) { wa[s] = *(const bf16x8*)(wga + 16 * s); wx[s] = *(const bf16x8*)(wgx + 16 * s); } }
    const int che = n * 128 + 32 * ct + r;
    const float ba = p.in[5][che], bx = p.in[7][che], lam = p.in[8][che];
    const float c8 = -8.0f * (fmaxf(-lam, 0.f) + log1pf(expf(-fabsf(lam))));
    const int ch2 = (tid & 63) * 2, tg = tid >> 6;
    float cw[4][2], cb[2];
#pragma unroll
    for (int k = 0; k < 4; ++k) { cw[k][0] = p.in[2][k * 1024 + n * 128 + ch2]; cw[k][1] = p.in[2][k * 1024 + n * 128 + ch2 + 1]; }
    cb[0] = p.in[3][n * 128 + ch2]; cb[1] = p.in[3][n * 128 + ch2 + 1];
    float hst = 0.f, Pst = 1.f;
    if (PASS == 2 && tid < 128) { for (int sg = 0; sg < seg; ++sg) { const f32x2 sv = SUM[(size_t)(b * 8 + sg) * 1024 + n * 128 + tid]; hst = sv.x * hst + sv.y; } }
    for (int c = 0; c < 16; ++c) {
        const int t0 = seg * 1024 + c * 64;
        __syncthreads();
        { float xa[11][2];
#pragma unroll
          for (int i = 0; i < 11; ++i) { const int t = t0 + tg * 8 - 3 + i; const unsigned v = (t >= 0) ? *(const unsigned*)(H0 + (tb + t) * H0W + n * 128 + ch2) : 0u; xa[i][0] = bflo(v); xa[i][1] = bfhi(v); }
#pragma unroll
          for (int i = 0; i < 8; ++i) { const int tl = tg * 8 + i;
              const float x0 = cb[0] + cw[0][0] * xa[i][0] + cw[1][0] * xa[i + 1][0] + cw[2][0] * xa[i + 2][0] + cw[3][0] * xa[i + 3][0];
              const float x1 = cb[1] + cw[0][1] * xa[i][1] + cw[1][1] * xa[i + 1][1] + cw[2][1] * xa[i + 2][1] + cw[3][1] * xa[i + 3][1];
              *(LAS f32x2*)(XCF + tl * 128 + ch2) = (f32x2){x0, x1}; *(LAS unsigned*)(XCB + tl * 136 + ch2) = pk2(x0, x1); } }
        __syncthreads();
        f32x16 ar, ai;
#pragma unroll
        for (int i = 0; i < 16; ++i) { ar[i] = 0.f; ai[i] = 0.f; }
#pragma unroll
        for (int s = 0; s < 8; ++s) { const bf16x8 af = *(const LAS bf16x8*)(XCB + (32 * tt + r) * 136 + 16 * s + 8 * hh); ar = MFMA32(af, wa[s], ar); ai = MFMA32(af, wx[s], ai); }
#pragma unroll
        for (int i = 0; i < 16; ++i) { const int tl = 32 * tt + (i & 3) + 8 * (i >> 2) + 4 * hh, cl = 32 * ct + r;
            const float rg = fsigmoid(ar[i] + ba), ig = fsigmoid(ai[i] + bx), la = rg * c8, a = __expf(la), y2 = 2.0f * la;
            float pp = 1.0f / 5040.0f; pp = pp * y2 + 1.0f / 720.0f; pp = pp * y2 + 1.0f / 120.0f; pp = pp * y2 + 1.0f / 24.0f; pp = pp * y2 + 1.0f / 6.0f; pp = pp * y2 + 0.5f; pp = pp * y2 + 1.0f;
            const float om = (y2 > -0.25f) ? (-y2 * pp) : (1.0f - __expf(y2));
            AF[tl * 128 + cl] = a; UF[tl * 128 + cl] = sqrtf(om) * ig * XCF[tl * 128 + cl]; }
        __syncthreads();
        if (tid < 128) {
#pragma unroll 16
            for (int t = 0; t < 64; ++t) { const float a = AF[t * 128 + tid], u = UF[t * 128 + tid]; hst = a * hst + u; if (PASS == 1) Pst *= a; if (PASS == 2) UF[t * 128 + tid] = hst; } }
        if (PASS == 2) { __syncthreads();
#pragma unroll
            for (int i = 0; i < 8; ++i) { const int tl = tg * 8 + i; const f32x2 hv = *(const LAS f32x2*)(UF + tl * 128 + ch2);
                const unsigned gv = *(const unsigned*)(H0 + (tb + t0 + tl) * H0W + 1024 + n * 128 + ch2);
                *(unsigned*)(Y0 + (tb + t0 + tl) * 2048 + n * 128 + ch2) = pk2(hv.x * fsilu(bflo(gv)), hv.y * fsilu(bfhi(gv))); } }
    }
    if (PASS == 1 && tid < 128) SUM[(size_t)(b * 8 + seg) * 1024 + n * 128 + tid] = (f32x2){Pst, hst};
}

#define XB_TMO      128
#define XB_XCNT(j)  (256  + 64 * (j))
#define XB_XSUB(j)  (1280 + 64 * (j))
#define XB_XGEN(j)  (2304 + 64 * (j))
#define XB_TOP      3328
#define XB_TOPGEN   3392
#define XCD_BAR_WORDS 3456
#define XB_SPIN_CAP (1u << 18)

__device__ __forceinline__ unsigned xb_ld(unsigned* p)              { return __hip_atomic_load(p, __ATOMIC_RELAXED, __HIP_MEMORY_SCOPE_AGENT); }
__device__ __forceinline__ unsigned xb_add(unsigned* p, unsigned v) { return __hip_atomic_fetch_add(p, v, __ATOMIC_RELAXED, __HIP_MEMORY_SCOPE_AGENT); }
__device__ __forceinline__ unsigned xb_xcc_id() { return (unsigned)__builtin_amdgcn_s_getreg((3 << 11) | 20) & 0xFu; }
#define XB_SPIN(cond, bar) do { unsigned _sp = 0; while (cond) { __builtin_amdgcn_s_sleep(1); \
    if ((++_sp & 255u) == 0u) { if (xb_ld(&(bar)[XB_TMO])) break; if (_sp > XB_SPIN_CAP) { atomicAdd(&(bar)[XB_TMO], 1u); break; } } } } while (0)

struct XcdBarrier {
    unsigned* bar; unsigned x;
    volatile LAS unsigned* st;
};

__device__ __forceinline__ XcdBarrier xcd_barrier_post(unsigned* bar, volatile LAS unsigned* st) {
    XcdBarrier b; b.bar = bar; b.x = xb_xcc_id(); b.st = st;
    if (threadIdx.x == 0) (void)xb_add(&bar[XB_XCNT(b.x)], 1u);
    return b;
}
__device__ __forceinline__ void xcd_barrier_complete(unsigned* bar, unsigned x, unsigned& nloc, unsigned& nx) {
    const unsigned G = gridDim.x * gridDim.y * gridDim.z;
    unsigned sum, cnt, mine, sp = 0u;
    for (;;) {
        sum = 0u; cnt = 0u; mine = 0u;
#pragma unroll
        for (unsigned j = 0; j < 16; ++j) { const unsigned c = xb_ld(&bar[XB_XCNT(j)]); sum += c; cnt += (c > 0u) ? 1u : 0u; mine = (j == x) ? c : mine; }
        if (sum == G) break;
        __builtin_amdgcn_s_sleep(1);
        if ((++sp & 255u) == 0u) { if (xb_ld(&bar[XB_TMO])) break; if (sp > XB_SPIN_CAP) { atomicAdd(&bar[XB_TMO], 1u); break; } }
    }
    nloc = mine > 0u ? mine : 1u; nx = cnt > 0u ? cnt : 1u;
}

__device__ __forceinline__ void xcd_barrier(const XcdBarrier& b) {
    asm volatile("s_waitcnt vmcnt(0)" ::: "memory");
    __syncthreads();
    if (threadIdx.x == 0) {
        unsigned* bar = b.bar;
        __builtin_amdgcn_s_waitcnt(0);
        unsigned nloc = b.st[0], nx = b.st[1];
        if (nloc == 0u) { xcd_barrier_complete(bar, b.x, nloc, nx); b.st[0] = nloc; b.st[1] = nx; }
        const unsigned old = xb_add(&bar[XB_XSUB(b.x)], 1u);
        const unsigned gen = old / nloc;
        if (old + 1u == (gen + 1u) * nloc) {
            __builtin_amdgcn_fence(__ATOMIC_RELEASE, "agent");
            asm volatile("s_waitcnt vmcnt(0)" ::: "memory");
            const unsigned og = xb_add(&bar[XB_TOP], 1u);
            const unsigned tg = og / nx;
            if (og + 1u == (tg + 1u) * nx) xb_add(&bar[XB_TOPGEN], 1u);
            else XB_SPIN(xb_ld(&bar[XB_TOPGEN]) == tg, bar);
            __builtin_amdgcn_fence(__ATOMIC_ACQUIRE, "agent");
            xb_add(&bar[XB_XGEN(b.x)], 1u);
            asm volatile("s_waitcnt vmcnt(0)" ::: "memory");
        } else {
            XB_SPIN(xb_ld(&bar[XB_XGEN(b.x)]) == gen, bar);
            __builtin_amdgcn_fence(__ATOMIC_ACQUIRE, "agent");
            asm volatile("s_waitcnt vmcnt(0)" ::: "memory");
        }
    }
    __syncthreads();
}

constexpr int LDS_BYTES = pg8::STAGE_BYTES + 16;
constexpr int N_PHASES = 10;
__global__ void __launch_bounds__(512) mk_fwd(Params p) {
    extern __shared__ __attribute__((aligned(16))) unsigned char lds_raw[];
    LAS unsigned char* lds = (LAS unsigned char*)lds_raw;
    const int tid = threadIdx.x, lane = tid & 63, wid = tid >> 6, G = gridDim.x, bx = blockIdx.x;
    unsigned char* ws = p.ws;
    bf16_t* W0T = (bf16_t*)(ws + WS_W0T); bf16_t* WO0T = (bf16_t*)(ws + WS_WO0T); bf16_t* W1T = (bf16_t*)(ws + WS_W1T); bf16_t* WO1T = (bf16_t*)(ws + WS_WO1T); bf16_t* WGT = (bf16_t*)(ws + WS_WGT);
    bf16_t* XB = (bf16_t*)(ws + WS_XB); bf16_t* VT0 = (bf16_t*)(ws + WS_VT0); bf16_t* H0 = (bf16_t*)(ws + WS_H0);
    float* X1 = (float*)(ws + WS_H0); bf16_t* X1B = XB; bf16_t* H1 = (bf16_t*)(ws + WS_H0 + 128 * MiB); bf16_t* KVT1 = (bf16_t*)(ws + WS_H0 + 276 * MiB); bf16_t* Y1 = VT0;
    bf16_t* Y0 = (bf16_t*)p.out;
#define IN(k) (lo <= (k) && (k) < hi)
    const int lo = p.ph_lo, hi = p.ph_hi;
    { volatile LAS unsigned* stw = (volatile LAS unsigned*)(lds + pg8::STAGE_BYTES); if (tid < 4) stw[tid] = 0u; }
    __syncthreads();
    const XcdBarrier gbar = xcd_barrier_post((unsigned*)(ws + WS_BAR), (volatile LAS unsigned*)(lds + pg8::STAGE_BYTES));
#define GSYNC() xcd_barrier(gbar)
#define SEAM(k) do { if (IN(k) && IN((k) + 1)) GSYNC(); } while (0)
    if (hi < 0) cg::this_grid().sync();
#define REPS(k) for (int rep_ = 0, nrep_ = (PROBE_DUP == (k) ? 2 : 1); rep_ < nrep_; ++rep_, (rep_ < nrep_ ? GSYNC() : (void)0))

    if (IN(0)) REPS(0) {
        cvt_x(p.in[0], XB, (size_t)bx * 512 + tid, (size_t)G * 512);
        LAS float* T = (LAS float*)lds;
        tr_cvt(p.in[1], 6144, 1024, 0, 4096, W0T, 0, T, bx, G);
        tr_cvt(p.in[1], 6144, 1024, 5120, 1024, W0T, 4096, T, bx, G);
        tr_cvt(p.in[1], 6144, 1024, 4096, 1024, W0T, 5120, T, bx, G);
        tr_cvt(p.in[9], 1024, 2048, 0, 1024, WO0T, 0, T, bx, G);
        tr_cvt(p.in[12], 2304, 1024, 0, 2304, W1T, 0, T, bx, G);
        tr_cvt(p.in[14], 1024, 1024, 0, 1024, WO1T, 0, T, bx, G);
        for (int n = 0; n < 8; ++n) { tr_cvt(p.in[4] + n * 16384, 128, 128, 0, 128, WGT + n * 16384, 0, T, (bx + 32 * n) % G, G); tr_cvt(p.in[6] + n * 16384, 128, 128, 0, 128, WGT + (8 + n) * 16384, 0, T, (bx + 32 * n + 16) % G, G); }
        __syncthreads();
    }
    SEAM(0);
    if (IN(1)) REPS(1) {
        { pg8::Gemm g{XB, W0T, NTOK, H0N, 1024}; pg8::StaticOrder S; S.init(NTOK, H0N, G, bx); pg8::EpiBf16<0> E{H0, H0W, nullptr, 0, 0};
          pg8::gemm_phase<pg8::EpiBf16<0>, pg8::StaticOrder>(lds, g, S, E, nullptr); }
        { pg8::Gemm g{W0T + (size_t)5120 * 1024, XB, 1024, NTOK, 1024}; pg8::StaticOrder S; S.init(1024, NTOK, G, bx); pg8::EpiBf16<0> E{VT0, VTP, nullptr, 0, 0};
          pg8::gemm_phase<pg8::EpiBf16<0>, pg8::StaticOrder>(lds, g, S, E, nullptr); }
    }
    SEAM(1);
    if (IN(2)) {
        REPS(2) { for (int item = bx; item < 256; item += G) lru_item<1>(p, lds, item); }
        REPS(12) for (int item = bx; item < 1024; item += G) sb_task(H0, VT0, Y0, item >> 8, (item >> 5) & 7, (item & 31) * 8 + wid, lane);
    }
    SEAM(2);
    if (IN(3)) REPS(3) { for (int item = bx; item < 256; item += G) lru_item<2>(p, lds, item); __syncthreads(); }
    SEAM(3);
    if (IN(4)) REPS(4) { pg8::Gemm g{Y0, WO0T, NTOK, 1024, 2048}; pg8::StaticOrder S; S.init(NTOK, 1024, G, bx); pg8::EpiResF32 E{X1, 1024, p.in[0], ALPHA};
        pg8::gemm_phase<pg8::EpiResF32, pg8::StaticOrder>(lds, g, S, E, nullptr); }
    SEAM(4);
    if (PROBE_DUP == 5) { ln_phase(X1, p.out, (bf16_t*)(ws + WS_VT0), p.in[10], p.in[11], bx * 8 + wid, G * 8, lane); GSYNC(); }
    if (IN(5)) ln_phase(X1, X1, X1B, p.in[10], p.in[11], bx * 8 + wid, G * 8, lane);
    SEAM(5);
    if (IN(6)) REPS(6) {
        { pg8::Gemm g{X1B, W1T, NTOK, H1N, 1024}; pg8::StaticOrder S; S.init(NTOK, H1N, G, bx); pg8::EpiBf16<0> E{H1, H1W, nullptr, 0, 0};
          pg8::gemm_phase<pg8::EpiBf16<0>, pg8::StaticOrder>(lds, g, S, E, nullptr); }
    }
    SEAM(6);
    if (IN(7)) REPS(7) { for (int item = bx; item < 2048; item += G) { const int qt = item & 255, c = (item >> 8) & 1, b = item >> 9; swa_item(H1, p.in[13], Y1, lds, b, c, qt); } }
    SEAM(7);
    if (IN(8)) REPS(8) { pg8::Gemm g{Y1, WO1T, NTOK, 1024, 1024}; pg8::StaticOrder S; S.init(NTOK, 1024, G, bx); pg8::EpiResF32 E{p.out, 1024, X1, ALPHA};
        pg8::gemm_phase<pg8::EpiResF32, pg8::StaticOrder>(lds, g, S, E, nullptr); }
    SEAM(8);
    if (PROBE_DUP == 9) { ln_phase(p.out, (float*)(ws + WS_H0 + 128 * MiB), nullptr, p.in[15], p.in[16], bx * 8 + wid, G * 8, lane); GSYNC(); }
    if (IN(9)) ln_phase(p.out, p.out, nullptr, p.in[15], p.in[16], bx * 8 + wid, G * 8, lane);
#undef IN
#undef SEAM
}

#ifndef MK_MULTI
#define MK_MULTI 0
#endif
extern "C" void kernel_launch(void* const* d_in, const int* in_sizes, int n_in, void* d_out, int out_size, void* d_ws, size_t ws_size, hipStream_t stream) {
    static int grid = 0;
    if (grid == 0) {
        if (n_in != 17 || out_size != NTOK * DM || ws_size < WS_END) { fprintf(stderr, "kernel_launch: unexpected shapes (n_in %d, out %d, ws %zu)\n", n_in, out_size, ws_size); grid = -1; return; }
        int dev = 0, cus = 0, per_cu = 0;
        hipGetDevice(&dev); hipDeviceGetAttribute(&cus, hipDeviceAttributeMultiprocessorCount, dev);
        if (hipFuncSetAttribute((const void*)mk_fwd, hipFuncAttributeMaxDynamicSharedMemorySize, LDS_BYTES) != hipSuccess) { fprintf(stderr, "kernel_launch: hipFuncSetAttribute failed\n"); grid = -1; return; }
        hipOccupancyMaxActiveBlocksPerMultiprocessor(&per_cu, (const void*)mk_fwd, 512, LDS_BYTES);
        (void)hipGetLastError();
        if (per_cu < 1) per_cu = 1;
        grid = cus;
    }
    if (grid < 0) return;
    Params p{};
    for (int i = 0; i < 17; ++i) p.in[i] = (const float*)d_in[i];
    p.out = (float*)d_out; p.ws = (unsigned char*)d_ws;
    (void)hipMemsetAsync((unsigned char*)d_ws + WS_BAR, 0, XCD_BAR_WORDS * 4, stream);
#if MK_MULTI
    for (int ph = 0; ph < N_PHASES; ++ph) { p.ph_lo = ph; p.ph_hi = ph + 1; hipLaunchKernelGGL(mk_fwd, dim3(grid), dim3(512), LDS_BYTES, stream, p); }
#else
    p.ph_lo = 0; p.ph_hi = N_PHASES;
    void* args[] = {&p};
    hipError_t e = hipLaunchCooperativeKernel((const void*)mk_fwd, dim3(grid), dim3(512), args, LDS_BYTES, stream);
    if (e != hipSuccess) fprintf(stderr, "cooperative launch failed: %s (grid %d)\n", hipGetErrorString(e), grid);
#endif
}
```

```cpp
#include <hip/hip_runtime.h>
#include <hip/hip_cooperative_groups.h>
#include <cstdio>
namespace cg = cooperative_groups;
#ifndef PROBE_DUP
#define PROBE_DUP -1
#endif
namespace pg8 {
#define PG8_LAS __attribute__((address_space(3)))
typedef unsigned short bf16_t;
typedef short bf16x8 __attribute__((ext_vector_type(8)));
typedef float f32x4 __attribute__((ext_vector_type(4)));
typedef unsigned u32x4 __attribute__((ext_vector_type(4)));
constexpr int BM = 256, BK = 64, HALF = 128, HTB = HALF * BK * 2  , STAGE_BYTES = 8 * HTB, NXCD = 8, WGM = 8;

__host__ __device__ __forceinline__ int lds_byte(int r, int c) { const int st = (r >> 4) * 2 + (c >> 5), rr = r & 15, cc = c & 31, ob = rr * 64 + cc * 2; return st * 1024 + (ob ^ (((ob >> 9) & 1) << 5)); }
__host__ __device__ __forceinline__ void stage_rc(int b, int& R, int& C) { const int st = b / 1024, sb = b % 1024, swz = sb ^ (((sb >> 9) & 1) << 5); R = (st >> 1) * 16 + swz / 64; C = (st & 1) * 32 + (swz % 64) / 2; }
__host__ __device__ __forceinline__ int perm32(int rho) { const int n = rho >> 4, i = rho & 15; return 8 * (i >> 2) + 4 * n + (i & 3); }

struct Unit { int pm, pn; };
struct Gemm { const bf16_t* A; const bf16_t* Bt; int M, N, K; };

struct StaticOrder {
    int nM, nN, nwg, G, c;
    __host__ __device__ void init(int M, int N, int G_, int c_) { nM = M / BM; nN = N / BM; nwg = nM * nN; G = G_; c = c_; }
    __host__ __device__ bool next(int i, Unit& u) const {
        const long L = (long)i * G + c; if (L >= nwg) return false;
        int wgid = (int)L; { const int q = nwg / NXCD, r = nwg % NXCD, xcd = wgid % NXCD, off = wgid / NXCD; wgid = (xcd < r ? xcd * (q + 1) : r * (q + 1) + (xcd - r) * q) + off; }
        const int nig = WGM * nN, gid = wgid / nig, fm = gid * WGM, gsz = (nM - fm) < WGM ? (nM - fm) : WGM;
        u.pm = fm + ((wgid % nig) % gsz); u.pn = (wgid % nig) / gsz; return true;
    }
    __device__ __forceinline__ void a_ready(const Unit&) const {}
    __device__ __forceinline__ void done(const Unit&) const {}
};

__device__ __forceinline__ unsigned cvt_pk_bf16(float lo, float hi) { unsigned r; asm volatile("v_cvt_pk_bf16_f32 %0, %1, %2" : "=v"(r) : "v"(lo), "v"(hi)); return r; }
typedef float f32x2 __attribute__((ext_vector_type(2)));
struct EpiF32 {
    static constexpr bool PERM = false, AFTER_DRAIN = false;
    float* C; int ldc; const float* bias;
    __device__ __forceinline__ void operator()(const f32x4 (&acc)[2][2][4][2], const Unit& u, int wr, int wc, int fr, int fq) const {
        const int row0 = u.pm * BM + wr * 64 + fr, col0 = u.pn * BM + wc * 32 + 4 * fq;
        f32x4 bv[2][2];
#pragma unroll
        for (int bj = 0; bj < 2; ++bj)
#pragma unroll
            for (int n = 0; n < 2; ++n) bv[bj][n] = bias ? *(const f32x4*)(bias + col0 + bj * HALF + n * 16) : (f32x4){0.f, 0.f, 0.f, 0.f};
#pragma unroll
        for (int ai = 0; ai < 2; ++ai)
#pragma unroll
            for (int m = 0; m < 4; ++m) { float* rowp = C + (size_t)(row0 + ai * HALF + m * 16) * ldc + col0;
#pragma unroll
                for (int bj = 0; bj < 2; ++bj)
#pragma unroll
                    for (int n = 0; n < 2; ++n) *(f32x4*)(rowp + bj * HALF + n * 16) = acc[ai][bj][m][n] + bv[bj][n]; }
    }
};
struct EpiResF32 {
    static constexpr bool PERM = false, AFTER_DRAIN = false;
    float* C; int ldc; const float* R; float alpha;
    __device__ __forceinline__ void operator()(const f32x4 (&acc)[2][2][4][2], const Unit& u, int wr, int wc, int fr, int fq) const {
        const int row0 = u.pm * BM + wr * 64 + fr, col0 = u.pn * BM + wc * 32 + 4 * fq;
#pragma unroll
        for (int ai = 0; ai < 2; ++ai)
#pragma unroll
            for (int m = 0; m < 4; ++m) { const size_t off = (size_t)(row0 + ai * HALF + m * 16) * ldc + col0;
#pragma unroll
                for (int bj = 0; bj < 2; ++bj)
#pragma unroll
                    for (int n = 0; n < 2; ++n) { const f32x4 rv = *(const f32x4*)(R + off + bj * HALF + n * 16); *(f32x4*)(C + off + bj * HALF + n * 16) = acc[ai][bj][m][n] + rv * alpha; } }
    }
};
template <int ACT  > struct EpiBf16 {
    static constexpr bool PERM = true, AFTER_DRAIN = false;
    bf16_t* O; int ldc; const float* bias; int split_cols; size_t split_stride;
    __device__ __forceinline__ void operator()(const f32x4 (&acc)[2][2][4][2], const Unit& u, int wr, int wc, int fr, int fq) const {
        const int row0 = u.pm * BM + wr * 64 + fr; int colt = u.pn * BM; bf16_t* base = O;
        if (split_cols) { const int t = colt / split_cols; base += (size_t)t * split_stride; colt -= t * split_cols; }
        const int col0 = colt + wc * 32 + 8 * fq, bcol0 = u.pn * BM + wc * 32 + 8 * fq;
        f32x4 bv[2][2];
#pragma unroll
        for (int bj = 0; bj < 2; ++bj)
#pragma unroll
            for (int n = 0; n < 2; ++n) bv[bj][n] = bias ? *(const f32x4*)(bias + bcol0 + bj * HALF + 4 * n) : (f32x4){0.f, 0.f, 0.f, 0.f};
#pragma unroll
        for (int ai = 0; ai < 2; ++ai)
#pragma unroll
            for (int m = 0; m < 4; ++m) { bf16_t* rowp = base + (size_t)(row0 + ai * HALF + m * 16) * ldc + col0;
#pragma unroll
                for (int bj = 0; bj < 2; ++bj) { f32x4 v0 = acc[ai][bj][m][0] + bv[bj][0], v1 = acc[ai][bj][m][1] + bv[bj][1];
                    u32x4 w; w.x = cvt_pk_bf16(v0[0], v0[1]); w.y = cvt_pk_bf16(v0[2], v0[3]); w.z = cvt_pk_bf16(v1[0], v1[1]); w.w = cvt_pk_bf16(v1[2], v1[3]);
                    *(u32x4*)(rowp + bj * HALF) = w; } }
    }
};
template <class Epi, class Sched, bool STAMP = false>
__device__ __forceinline__ void gemm_phase(PG8_LAS unsigned char* lds, const Gemm g, const Sched& S, const Epi& E, unsigned long long* stamps) {
    const int tid = threadIdx.x, wid = __builtin_amdgcn_readfirstlane(tid >> 6), lane = tid & 63, wr = wid >> 2, wc = wid & 3, fr = lane & 15, fq = lane >> 4;
    const int K = g.K, nt = K / BK;
    int ts_lo = 0, ts_hi = 0, nts = 0; const unsigned long long rt_entry = STAMP ? (unsigned long long)wall_clock64() : 0ull;
#define PG8_STAMP() do { if (STAMP && wid == 0 && nts < 64) { const unsigned long long _c = (unsigned long long)clock64(); \
        ts_lo = (lane == nts) ? (int)(unsigned)_c : ts_lo; ts_hi = (lane == nts) ? (int)(unsigned)(_c >> 32) : ts_hi; ++nts; } } while (0)
    PG8_STAMP();
    unsigned voffA[2], voffB[2];
#pragma unroll
    for (int i = 0; i < 2; ++i) { int R, C; stage_rc(tid * 16 + i * 8192, R, C); const int Rb = Epi::PERM ? ((R & ~31) + perm32(R & 31)) : R;
        voffA[i] = (unsigned)(R * K + C) * 2u; voffB[i] = (unsigned)(Rb * K + C) * 2u; }
    const size_t kstep = (size_t)(BK * 2);
    const size_t hstep = (size_t)HALF * K * 2;
    const size_t tstep = 2 * hstep;
    const unsigned ldsw = (unsigned)wid * 1024u;
    const int aoff = lds_byte(wr * 64 + fr, fq * 8), boff = lds_byte(wc * 32 + fr, fq * 8);
#define PG8_SA(b, h) (((b) * 2 + (h)) * HTB)
#define PG8_SB(b, h) ((4 + (b) * 2 + (h)) * HTB)
#define PG8_STAGE(bufoff, gbase, voff) do { _Pragma("unroll") for (int _i = 0; _i < 2; ++_i) \
        __builtin_amdgcn_global_load_lds((const unsigned*)((const char*)(gbase) + (voff)[_i]), (PG8_LAS unsigned*)(lds + (bufoff) + ldsw + _i * 8192), 16, 0, 0); } while (0)
#define PG8_LDA(dst, b, h) do { _Pragma("unroll") for (int m = 0; m < 4; ++m) _Pragma("unroll") for (int k = 0; k < 2; ++k) dst[m][k] = *(const PG8_LAS bf16x8*)(lds + PG8_SA(b, h) + aoff + m * 2048 + k * 1024); } while (0)
#define PG8_LDB(dst, b, h) do { _Pragma("unroll") for (int n = 0; n < 2; ++n) _Pragma("unroll") for (int k = 0; k < 2; ++k) dst[n][k] = *(const PG8_LAS bf16x8*)(lds + PG8_SB(b, h) + boff + n * 2048 + k * 1024); } while (0)
#define PG8_MMA(ai, bj, At, Bt) do { __builtin_amdgcn_s_setprio(1); _Pragma("unroll") for (int m = 0; m < 4; ++m) _Pragma("unroll") for (int n = 0; n < 2; ++n) _Pragma("unroll") for (int k = 0; k < 2; ++k) \
        acc[ai][bj][m][n] = __builtin_amdgcn_mfma_f32_16x16x32_bf16(Bt[n][k], At[m][k], acc[ai][bj][m][n], 0, 0, 0); __builtin_amdgcn_s_setprio(0); } while (0)
#define PG8_WAIT_V(n) asm volatile("s_waitcnt vmcnt(" #n ")" ::: "memory")
#define PG8_WAIT_L(n) asm volatile("s_waitcnt lgkmcnt(" #n ")" ::: "memory")
#define PG8_BAR __builtin_amdgcn_s_barrier()
#define PG8_SCHED __builtin_amdgcn_sched_barrier(0)
    Unit cur, nxt; int ui = 0;
    if (!S.next(0, cur)) return;
    f32x4 acc[2][2][4][2];
#pragma unroll
    for (int a = 0; a < 2; ++a)
#pragma unroll
        for (int b = 0; b < 2; ++b)
#pragma unroll
            for (int m = 0; m < 4; ++m)
#pragma unroll
                for (int n = 0; n < 2; ++n) acc[a][b][m][n] = (f32x4){0.f, 0.f, 0.f, 0.f};
    bf16x8 At[4][2], B0[2][2], B1[2][2];
    const char* cA = (const char*)g.A + (size_t)cur.pm * tstep; const char* cB = (const char*)g.Bt + (size_t)cur.pn * tstep;
    S.a_ready(cur);
    PG8_STAGE(PG8_SB(0, 0), cB, voffB); PG8_STAGE(PG8_SA(0, 0), cA, voffA); PG8_STAGE(PG8_SB(0, 1), cB + hstep, voffB); PG8_STAGE(PG8_SA(0, 1), cA + hstep, voffA);
    if (wr == 1) PG8_BAR;
    PG8_WAIT_V(4); PG8_BAR;
    PG8_STAGE(PG8_SB(1, 0), cB + kstep, voffB); PG8_STAGE(PG8_SA(1, 0), cA + kstep, voffA); PG8_STAGE(PG8_SB(1, 1), cB + hstep + kstep, voffB);
    PG8_WAIT_V(6); PG8_BAR;
    PG8_STAMP();
    for (;;) {
        const bool has_next = S.next(ui + 1, nxt);
        const char* nA = has_next ? (const char*)g.A + (size_t)nxt.pm * tstep : cA; const char* nB = has_next ? (const char*)g.Bt + (size_t)nxt.pn * tstep : cB;
        for (int t = 0; t < nt; t += 2) {
            const bool last = (t == nt - 2);
            const char* a1 = cA + (size_t)(t + 1) * kstep;
            const char* a2 = last ? nA : cA + (size_t)(t + 2) * kstep; const char* b2 = last ? nB : cB + (size_t)(t + 2) * kstep;
            const char* a3 = a2 + kstep; const char* b3 = b2 + kstep;
            if (last && has_next) S.a_ready(nxt);
            PG8_LDB(B0, 0, 0); PG8_SCHED; PG8_LDA(At, 0, 0); PG8_STAGE(PG8_SA(1, 1), a1 + hstep, voffA);
            PG8_WAIT_L(8); PG8_BAR; PG8_WAIT_L(0); PG8_MMA(0, 0, At, B0); PG8_BAR; PG8_SCHED;
            PG8_LDB(B1, 0, 1); PG8_STAGE(PG8_SB(0, 0), b2, voffB);
            PG8_BAR; PG8_WAIT_L(0); PG8_MMA(0, 1, At, B1); PG8_BAR;
            PG8_LDA(At, 0, 1); PG8_STAGE(PG8_SA(0, 0), a2, voffA);
            PG8_BAR; PG8_WAIT_L(0); PG8_MMA(1, 0, At, B0); PG8_BAR; PG8_SCHED;
            PG8_STAGE(PG8_SB(0, 1), b2 + hstep, voffB);
            PG8_WAIT_V(6); PG8_BAR; PG8_MMA(1, 1, At, B1); PG8_BAR;
            PG8_LDB(B0, 1, 0); PG8_SCHED; PG8_LDA(At, 1, 0); PG8_STAGE(PG8_SA(0, 1), a2 + hstep, voffA);
            PG8_WAIT_L(8); PG8_BAR; PG8_WAIT_L(0); PG8_MMA(0, 0, At, B0); PG8_BAR; PG8_SCHED;
            PG8_LDB(B1, 1, 1); PG8_STAGE(PG8_SB(1, 0), b3, voffB);
            PG8_BAR; PG8_WAIT_L(0); PG8_MMA(0, 1, At, B1); PG8_BAR;
            PG8_LDA(At, 1, 1); PG8_STAGE(PG8_SA(1, 0), a3, voffA);
            PG8_BAR; PG8_WAIT_L(0); PG8_MMA(1, 0, At, B0); PG8_BAR; PG8_SCHED;
            PG8_STAGE(PG8_SB(1, 1), b3 + hstep, voffB);
            PG8_WAIT_V(6); PG8_BAR; PG8_MMA(1, 1, At, B1); PG8_BAR;
        }
        PG8_STAMP();
        if constexpr (!Epi::AFTER_DRAIN) { E(acc, cur, wr, wc, fr, fq); S.done(cur); }
        PG8_STAMP();
        if (!has_next) break;
#pragma unroll
        for (int a = 0; a < 2; ++a)
#pragma unroll
            for (int b = 0; b < 2; ++b)
#pragma unroll
                for (int m = 0; m < 4; ++m)
#pragma unroll
                    for (int n = 0; n < 2; ++n) acc[a][b][m][n] = (f32x4){0.f, 0.f, 0.f, 0.f};
        cur = nxt; cA = nA; cB = nB; ++ui;
    }
    PG8_WAIT_V(0);
    if (wr == 0) PG8_BAR;
    PG8_BAR;
    if constexpr (Epi::AFTER_DRAIN) { E.fused(acc, cur, wr, wc, fr, fq, lds, wid, lane); S.done(cur); }
    PG8_STAMP();
    if (STAMP && wid == 0) { stamps[lane] = lane < nts ? (((unsigned long long)(unsigned)ts_hi << 32) | (unsigned)ts_lo) : 0ull;
        if (lane == 62) stamps[62] = rt_entry; if (lane == 63) stamps[63] = (unsigned long long)wall_clock64(); }
#undef PG8_STAMP
#undef PG8_SA
#undef PG8_SB
#undef PG8_STAGE
#undef PG8_LDA
#undef PG8_LDB
#undef PG8_MMA
#undef PG8_WAIT_V
#undef PG8_WAIT_L
#undef PG8_BAR
#undef PG8_SCHED
}
}

#define LAS __attribute__((address_space(3)))
typedef unsigned short bf16_t;
typedef short bf16x8 __attribute__((ext_vector_type(8)));
typedef float f32x4 __attribute__((ext_vector_type(4)));
typedef float f32x2 __attribute__((ext_vector_type(2)));
typedef float f32x16 __attribute__((ext_vector_type(16)));
typedef unsigned u32x4 __attribute__((ext_vector_type(4)));
typedef unsigned u32x2 __attribute__((ext_vector_type(2)));

constexpr int NTOK = 32768, SEQ = 8192, DM = 1024;
constexpr int H0W = 6208;
constexpr int H0N = 6144;
constexpr int H1W = 2368;
constexpr int H1N = 2304;
constexpr float ALPHA = 1.4142135623730951f;
constexpr float LN_EPS = 1e-5f;
constexpr size_t MiB = 1ull << 20;
constexpr size_t WS_W0T = 0;
constexpr size_t WS_WO0T = 12 * MiB;
constexpr size_t WS_W1T = 16 * MiB;
constexpr size_t WS_WO1T = 21 * MiB;
constexpr size_t WS_WGT = 23 * MiB;
constexpr size_t WS_SUM = 24 * MiB;
constexpr size_t WS_BAR = 25 * MiB;
constexpr size_t WS_XB = 32 * MiB;
constexpr size_t WS_H0 = 96 * MiB;
constexpr size_t WS_END = 484 * MiB;

struct Params { const float* in[17]; float* out; unsigned char* ws; int ph_lo, ph_hi; };

__device__ __forceinline__ unsigned pk2(float lo, float hi) { return pg8::cvt_pk_bf16(lo, hi); }
__device__ __forceinline__ float bflo(unsigned v) { return __uint_as_float(v << 16); }
__device__ __forceinline__ float bfhi(unsigned v) { return __uint_as_float(v & 0xffff0000u); }
__device__ __forceinline__ float fsigmoid(float x) { return __builtin_amdgcn_rcpf(1.0f + __expf(-x)); }
__device__ __forceinline__ float fsilu(float x) { return x * fsigmoid(x); }
__device__ __forceinline__ float wave_sum(float v) {
#pragma unroll
    for (int o = 32; o >= 1; o >>= 1) v += __shfl_xor(v, o);
    return v; }
__device__ __forceinline__ int pi32(int r) { return (r & 0x13) | ((r & 4) << 1) | ((r & 8) >> 1); }
#define MFMA32(a, b, c) __builtin_amdgcn_mfma_f32_32x32x16_bf16((a), (b), (c), 0, 0, 0)

__device__ __forceinline__ void cvt_x(const float* __restrict__ x, bf16_t* __restrict__ xb, size_t gtid, size_t gthreads) {
    for (size_t i = gtid; i < (size_t)NTOK * DM / 8; i += gthreads) {
        const f32x4 a = *(const f32x4*)(x + i * 8), b = *(const f32x4*)(x + i * 8 + 4);
        u32x4 w; w.x = pk2(a[0], a[1]); w.y = pk2(a[2], a[3]); w.z = pk2(b[0], b[1]); w.w = pk2(b[2], b[3]);
        *(u32x4*)(xb + i * 8) = w; }
}
__device__ __forceinline__ void tr_cvt(const float* __restrict__ src, int ld, int K, int scol0, int ncols, bf16_t* __restrict__ dst, int drow0, LAS float* T, int blk, int nblk) {
    const int tid = threadIdx.x, tk = K / 64, tn = ncols / 64;
    for (int t = blk; t < tk * tn; t += nblk) {
        const int k0 = (t % tk) * 64, n0 = (t / tk) * 64;
        __syncthreads();
#pragma unroll
        for (int i = 0; i < 2; ++i) { const int kr = (tid >> 4) + 32 * i, c4 = (tid & 15) * 4;
            const f32x4 v = *(const f32x4*)(src + (size_t)(k0 + kr) * ld + scol0 + n0 + c4);
            T[kr * 65 + c4] = v[0]; T[kr * 65 + c4 + 1] = v[1]; T[kr * 65 + c4 + 2] = v[2]; T[kr * 65 + c4 + 3] = v[3]; }
        __syncthreads();
        { const int n = tid >> 3, k8 = (tid & 7) * 8; float v[8];
#pragma unroll
            for (int j = 0; j < 8; ++j) v[j] = T[(k8 + j) * 65 + n];
            u32x4 w; w.x = pk2(v[0], v[1]); w.y = pk2(v[2], v[3]); w.z = pk2(v[4], v[5]); w.w = pk2(v[6], v[7]);
            *(u32x4*)(dst + (size_t)(drow0 + n0 + n) * K + k0 + k8) = w; }
    }
}

__device__ __forceinline__ void ln_phase(const float* z, float* of, bf16_t* ob, const float* __restrict__ g, const float* __restrict__ bta, int gwave, int ngwaves, int lane) {
    f32x4 gv[4], bv[4];
#pragma unroll
    for (int i = 0; i < 4; ++i) { gv[i] = *(const f32x4*)(g + i * 256 + lane * 4); bv[i] = *(const f32x4*)(bta + i * 256 + lane * 4); }
    for (int row = gwave; row < NTOK; row += ngwaves) {
        const float* zr = z + (size_t)row * DM; f32x4 v[4];
#pragma unroll
        for (int i = 0; i < 4; ++i) v[i] = *(const f32x4*)(zr + i * 256 + lane * 4);
        float s = 0.f;
#pragma unroll
        for (int i = 0; i < 4; ++i) s += (v[i][0] + v[i][1]) + (v[i][2] + v[i][3]);
        const float mean = wave_sum(s) * (1.0f / 1024.0f);
        float q = 0.f;
#pragma unroll
        for (int i = 0; i < 4; ++i) { const f32x4 d = v[i] - mean; q += (d[0] * d[0] + d[1] * d[1]) + (d[2] * d[2] + d[3] * d[3]); }
        const float rstd = rsqrtf(wave_sum(q) * (1.0f / 1024.0f) + LN_EPS);
#pragma unroll
        for (int i = 0; i < 4; ++i) { const f32x4 y = (v[i] - mean) * rstd * gv[i] + bv[i];
            *(f32x4*)(of + (size_t)row * DM + i * 256 + lane * 4) = y;
            if (ob) { u32x2 w; w.x = pk2(y[0], y[1]); w.y = pk2(y[2], y[3]); *(u32x2*)(ob + (size_t)row * DM + i * 256 + lane * 4) = w; } }
    }
}

typedef short s16x4 __attribute__((ext_vector_type(4)));
constexpr int SB_SLOT = 16384, SB_NSLOT = 9, SB_LDS = SB_SLOT * SB_NSLOT;
__device__ __forceinline__ int sb_off(int row, int ch) { return 256 * row + 16 * (ch ^ (((row & 3) << 2) | ((row >> 2) & 3))); }
__device__ __forceinline__ int sb_slot(int j) { return ((j % SB_NSLOT) + SB_NSLOT) % SB_NSLOT; }
__device__ __forceinline__ void sb_item(const bf16_t* __restrict__ H0, bf16_t* __restrict__ Y0, LAS unsigned char* lds, int b, int h, int qg) {
    const int tid = threadIdx.x, lane = tid & 63, wid = tid >> 6;
    const int r = lane & 31, hh = lane >> 5, pr = pi32(r), qt = qg * 8 + wid, q0 = qt * 32, B0 = qg * 8;
    const size_t tb = (size_t)b * SEQ;
    const float SCALE = 0.08838834764831845f;
    const int srow = tid >> 4, sch = tid & 15;
    const bf16_t* sbase = H0 + (tb + srow) * H0W + 3072 + h * 128 + sch * 8;
    const int skoff = sb_off(pi32(srow), sch), svoff = 8192 + sb_off(srow, sch);
    __syncthreads();
    { u32x4 kv[8], vv[8];
#pragma unroll
      for (int j = 0; j < 8; ++j) { const bf16_t* src = sbase + (size_t)(32 * (B0 + j)) * H0W; kv[j] = *(const u32x4*)src; vv[j] = *(const u32x4*)(src + 2048); }
#pragma unroll
      for (int j = 0; j < 8; ++j) { LAS unsigned char* sl = lds + sb_slot(j) * SB_SLOT; *(LAS u32x4*)(sl + skoff) = kv[j]; *(LAS u32x4*)(sl + svoff) = vv[j]; } }
    bf16x8 qf[8];
    { const bf16_t* qrow = H0 + (tb + q0 + r) * H0W + 2048 + h * 128 + 8 * hh;
#pragma unroll
      for (int s = 0; s < 8; ++s) qf[s] = *(const bf16x8*)(qrow + 16 * s); }
    bf16x8 uf[2];
#pragma unroll
    for (int s = 0; s < 2; ++s)
#pragma unroll
        for (int j = 0; j < 8; ++j) uf[s][j] = (16 * s + 8 * hh + j > pr) ? (short)0x3F80 : (short)0;
    f32x16 o[4];
#pragma unroll
    for (int dt = 0; dt < 4; ++dt)
#pragma unroll
        for (int i = 0; i < 16; ++i) o[dt][i] = 0.f;
    float carry = 0.f;
    const int kx = ((r & 3) << 2) | ((r >> 2) & 3), krow = 256 * r;
    const int vq = (lane & 15) >> 2, vp = lane & 3, vblk = (lane >> 4) & 1;
    int cv[4][2];
#pragma unroll
    for (int c = 0; c < 4; ++c)
#pragma unroll
        for (int t = 0; t < 2; ++t) cv[c][t] = 8192 + 256 * (8 * hh + 4 * t + vq) + 16 * ((((c ^ vq) & 3) << 2) | ((vblk ^ hh) << 1) | ((vp >> 1) ^ t)) + 8 * (vp & 1);
    __syncthreads();
    int done = 0;
    for (int i = 0; ; ++i) {
        const int kb = qt - i, nb = B0 - i - 1;
        u32x4 nk = (u32x4){0u, 0u, 0u, 0u}, nv = (u32x4){0u, 0u, 0u, 0u};
        if (nb >= 0) { const bf16_t* src = sbase + (size_t)(32 * nb) * H0W; nk = *(const u32x4*)src; nv = *(const u32x4*)(src + 2048); }
        if (!done) {
            LAS unsigned char* sl = lds + sb_slot(wid - i) * SB_SLOT;
            f32x16 st;
#pragma unroll
            for (int k = 0; k < 16; ++k) st[k] = 0.f;
#pragma unroll
            for (int s = 0; s < 8; ++s) { const bf16x8 kf = *(const LAS bf16x8*)(sl + krow + 16 * ((2 * s + hh) ^ kx)); st = MFMA32(kf, qf[s], st); }
            const bool diag = (i == 0);
            float L[16], lb[16]; float psum = 0.f;
#pragma unroll
            for (int k = 0; k < 16; ++k) {
                const float z = st[k] * SCALE;
                const float sp = fmaxf(z, 0.f) + __logf(1.0f + __expf(-fabsf(z)));
                const int key = 16 * (k >> 3) + 8 * hh + (k & 7);
                const bool valid = !diag || (key < r);
                L[k] = valid ? -sp : 0.f; lb[k] = valid ? (z - sp) : -1e30f; psum += L[k]; }
            const float tot = psum + __shfl_xor(psum, 32);
            union { bf16x8 v; unsigned u[4]; } hi[2], lo[2], pf[2];
#pragma unroll
            for (int s = 0; s < 2; ++s)
#pragma unroll
                for (int jj = 0; jj < 4; ++jj) { const float a0 = L[8 * s + 2 * jj], a1 = L[8 * s + 2 * jj + 1];
                    const unsigned ph = pk2(a0, a1); hi[s].u[jj] = ph; lo[s].u[jj] = pk2(a0 - bflo(ph), a1 - bfhi(ph)); }
            f32x16 suf;
#pragma unroll
            for (int k = 0; k < 16; ++k) suf[k] = 0.f;
#pragma unroll
            for (int s = 0; s < 2; ++s) { suf = MFMA32(uf[s], hi[s].v, suf); suf = MFMA32(uf[s], lo[s].v, suf); }
            float w[16];
#pragma unroll
            for (int k = 0; k < 16; ++k) w[k] = __expf(lb[k] + suf[k] + carry);
            carry += tot;
#pragma unroll
            for (int s = 0; s < 2; ++s)
#pragma unroll
                for (int jj = 0; jj < 4; ++jj) pf[s].u[jj] = pk2(w[8 * s + 2 * jj], w[8 * s + 2 * jj + 1]);
#pragma unroll
            for (int dt = 0; dt < 4; ++dt)
#pragma unroll
                for (int s = 0; s < 2; ++s) { union { bf16x8 v; s16x4 hq[2]; } vf;
#pragma unroll
                    for (int t = 0; t < 2; ++t) vf.hq[t] = __builtin_amdgcn_ds_read_tr16_b64_v4i16((LAS s16x4*)(sl + cv[dt][t] + 4096 * s));
                    o[dt] = MFMA32(vf.v, pf[s].v, o[dt]); }
            if (kb == 0 || __all(carry < -110.0f)) done = 1;
        }
        if (nb >= 0) { LAS unsigned char* sl = lds + sb_slot(-i - 1) * SB_SLOT; *(LAS u32x4*)(sl + skoff) = nk; *(LAS u32x4*)(sl + svoff) = nv; }
        { volatile LAS unsigned* fl = (volatile LAS unsigned*)(lds + SB_LDS + 16) + 8 * (i & 1);
          if (lane == 0) fl[wid] = (unsigned)done;
          __syncthreads();
          const unsigned alld = fl[0] & fl[1] & fl[2] & fl[3] & fl[4] & fl[5] & fl[6] & fl[7];
          if (alld) break; }
    }
    const size_t tok = tb + q0 + r;
#pragma unroll
    for (int dt = 0; dt < 4; ++dt)
#pragma unroll
        for (int g4 = 0; g4 < 4; ++g4) { const int d0 = 32 * dt + 8 * g4 + 4 * hh;
            const u32x2 gv = *(const u32x2*)(H0 + tok * H0W + 4096 + h * 128 + d0);
            const float y0 = o[dt][4 * g4] * fsilu(bflo(gv.x)), y1 = o[dt][4 * g4 + 1] * fsilu(bfhi(gv.x)), y2 = o[dt][4 * g4 + 2] * fsilu(bflo(gv.y)), y3 = o[dt][4 * g4 + 3] * fsilu(bfhi(gv.y));
            u32x2 wv; wv.x = pk2(y0, y1); wv.y = pk2(y2, y3);
            *(u32x2*)(Y0 + tok * 2048 + 1024 + h * 128 + d0) = wv; }
}

constexpr int SWA_K = 0, SWA_V = 23040, SWA_Q = 53760, SWA_G = 87040;
constexpr int SWA_KP = 144, SWA_VP = 192, SWA_QP = 1040;
__device__ __forceinline__ void swa_item(const bf16_t* __restrict__ H1, const float* __restrict__ sinks, bf16_t* __restrict__ Y1, LAS unsigned char* lds, int b, int c, int qt) {
    const int tid = threadIdx.x, lane = tid & 63, wid = tid >> 6;
    const int r = lane & 31, hh = lane >> 5, pr = pi32(r), q0 = qt * 32, hc = c * 8 + wid;
    const size_t tb = (size_t)b * SEQ;
    const float slope = exp2f(-0.5f * (float)(hc + 1)), sink = sinks[hc];
    __syncthreads();
#pragma unroll
    for (int i = 0; i < 3; ++i) { const int idx = tid + 512 * i;
        if (idx < 1280) { const int row = idx >> 3, ch = idx & 7, t = q0 - 128 + row; u32x4 kv = (u32x4){0u, 0u, 0u, 0u}, vv = (u32x4){0u, 0u, 0u, 0u};
            if (t >= 0) { const bf16_t* src = H1 + (tb + t) * H1W + 1024 + c * 64 + ch * 8; kv = *(const u32x4*)src; vv = *(const u32x4*)(src + 128); }
            *(LAS u32x4*)(lds + SWA_K + row * SWA_KP + ch * 16) = kv; *(LAS u32x4*)(lds + SWA_V + row * SWA_VP + ch * 16) = vv; } }
#pragma unroll
    for (int i = 0; i < 4; ++i) { const int idx = tid + 512 * i, row = idx >> 6, ch = idx & 63; const bf16_t* src = H1 + (tb + q0 + row) * H1W + c * 512 + ch * 8;
        const u32x4 qv = *(const u32x4*)src, gq = *(const u32x4*)(src + 1280);
        *(LAS u32x4*)(lds + SWA_Q + row * SWA_QP + ch * 16) = qv; *(LAS u32x4*)(lds + SWA_G + row * SWA_QP + ch * 16) = gq; }
    __syncthreads();
    bf16x8 qf[4];
#pragma unroll
    for (int s = 0; s < 4; ++s) qf[s] = *(const LAS bf16x8*)(lds + SWA_Q + r * SWA_QP + wid * 128 + 32 * s + 16 * hh);
    __syncthreads();
    f32x16 o[2];
#pragma unroll
    for (int dt = 0; dt < 2; ++dt)
#pragma unroll
        for (int i = 0; i < 16; ++i) o[dt][i] = 0.f;
    float m = sink, l = 1.0f;
    const int vlane = 32 * ((lane >> 4) & 1) + 8 * (lane & 3) + SWA_VP * (8 * hh + ((lane & 15) >> 2));
#pragma unroll 1
    for (int j = 0; j < 5; ++j) {
        f32x16 st;
#pragma unroll
        for (int i = 0; i < 16; ++i) st[i] = 0.f;
#pragma unroll
        for (int s = 0; s < 4; ++s) { const bf16x8 kf = *(const LAS bf16x8*)(lds + SWA_K + (32 * j + pr) * SWA_KP + 32 * s + 16 * hh); st = MFMA32(kf, qf[s], st); }
        union { bf16x8 v; s16x4 h[2]; } vf[2][2];
#pragma unroll
        for (int dt = 0; dt < 2; ++dt)
#pragma unroll
            for (int s = 0; s < 2; ++s)
#pragma unroll
                for (int t = 0; t < 2; ++t) vf[dt][s].h[t] = __builtin_amdgcn_ds_read_tr16_b64_v4i16((LAS s16x4*)(lds + SWA_V + (32 * j + 16 * s + 4 * t) * SWA_VP + 64 * dt + vlane));
        float bmax = -1e30f;
#pragma unroll
        for (int i = 0; i < 16; ++i) { const int dist = r - (32 * (j - 4) + 16 * (i >> 3) + 8 * hh + (i & 7));
            const bool valid = dist >= 0 && dist < 128 && dist <= q0 + r;
            st[i] = valid ? (st[i] * 0.125f - slope * (float)dist) : -1e30f; bmax = fmaxf(bmax, st[i]); }
        bmax = fmaxf(bmax, __shfl_xor(bmax, 32));
        const float mn = fmaxf(m, bmax), al = __expf(m - mn);
        float psum = 0.f;
#pragma unroll
        for (int i = 0; i < 16; ++i) { st[i] = __expf(st[i] - mn); psum += st[i]; }
        psum += __shfl_xor(psum, 32);
        l = l * al + psum; m = mn;
#pragma unroll
        for (int dt = 0; dt < 2; ++dt)
#pragma unroll
            for (int i = 0; i < 16; ++i) o[dt][i] *= al;
        union { bf16x8 v; unsigned u[4]; } pf[2];
#pragma unroll
        for (int s = 0; s < 2; ++s)
#pragma unroll
            for (int jj = 0; jj < 4; ++jj) pf[s].u[jj] = pk2(st[8 * s + 2 * jj], st[8 * s + 2 * jj + 1]);
#pragma unroll
        for (int dt = 0; dt < 2; ++dt)
#pragma unroll
            for (int s = 0; s < 2; ++s) o[dt] = MFMA32(vf[dt][s].v, pf[s].v, o[dt]);
    }
    const float inv = __builtin_amdgcn_rcpf(l);
#pragma unroll
    for (int dt = 0; dt < 2; ++dt)
#pragma unroll
        for (int g4 = 0; g4 < 4; ++g4) { const int boff = r * SWA_QP + wid * 128 + (32 * dt + 8 * g4 + 4 * hh) * 2; const u32x2 g = *(const LAS u32x2*)(lds + SWA_G + boff);
            const float y0 = o[dt][4 * g4] * inv * fsilu(bflo(g.x)), y1 = o[dt][4 * g4 + 1] * inv * fsilu(bfhi(g.x)), y2 = o[dt][4 * g4 + 2] * inv * fsilu(bflo(g.y)), y3 = o[dt][4 * g4 + 3] * inv * fsilu(bfhi(g.y));
            u32x2 wv; wv.x = pk2(y0, y1); wv.y = pk2(y2, y3);
            *(LAS u32x2*)(lds + SWA_Q + boff) = wv; }
    __syncthreads();
#pragma unroll
    for (int i = 0; i < 4; ++i) { const int idx = tid + 512 * i, row = idx >> 6, ch = idx & 63;
        *(u32x4*)(Y1 + (tb + q0 + row) * 1024 + c * 512 + ch * 8) = *(const LAS u32x4*)(lds + SWA_Q + row * SWA_QP + ch * 16); }
}

constexpr int LRU_XCB = 0, LRU_XCF = 17408, LRU_AF = LRU_XCF + 32768, LRU_UF = LRU_AF + 32768;
template <int PASS>
__device__ __forceinline__ void lru_item(const Params& p, LAS unsigned char* lds, int item) {
    const int tid = threadIdx.x, lane = tid & 63, wid = tid >> 6;
    const int pair = item & 31, seg = item >> 5, b = pair >> 3, n = pair & 7;
    const size_t tb = (size_t)b * SEQ;
    const bf16_t* H0 = (const bf16_t*)(p.ws + WS_H0); const bf16_t* WGT = (const bf16_t*)(p.ws + WS_WGT);
    f32x2* SUM = (f32x2*)(p.ws + WS_SUM); bf16_t* Y0 = (bf16_t*)p.out;
    LAS bf16_t* XCB = (LAS bf16_t*)(lds + LRU_XCB); LAS float* XCF = (LAS float*)(lds + LRU_XCF); LAS float* AF = (LAS float*)(lds + LRU_AF); LAS float* UF = (LAS float*)(lds + LRU_UF);
    const int r = lane & 31, hh = lane >> 5, ct = wid & 3, tt = wid >> 2;
    bf16x8 wa[8], wx[8];
    { const bf16_t* wga = WGT + ((size_t)(n) * 128 + 32 * ct + r) * 128 + 8 * hh; const bf16_t* wgx = WGT + ((size_t)(8 + n) * 128 + 32 * ct + r) * 128 + 8 * hh;
#pragma unroll
      for (int s = 0; s < 8; ++s) { wa[s] = *(const bf16x8*)(wga + 16 * s); wx[s] = *(const bf16x8*)(wgx + 16 * s); } }
    const int che = n * 128 + 32 * ct + r;
    const float ba = p.in[5][che], bx = p.in[7][che], lam = p.in[8][che];
    const float c8 = -8.0f * (fmaxf(-lam, 0.f) + log1pf(expf(-fabsf(lam))));
    const int ch2 = (tid & 63) * 2, tg = tid >> 6;
    float cw[4][2], cb[2];
#pragma unroll
    for (int k = 0; k < 4; ++k) { cw[k][0] = p.in[2][k * 1024 + n * 128 + ch2]; cw[k][1] = p.in[2][k * 1024 + n * 128 + ch2 + 1]; }
    cb[0] = p.in[3][n * 128 + ch2]; cb[1] = p.in[3][n * 128 + ch2 + 1];
    const int sch = tid & 127, sgrp = tid >> 7;
    float hst = 0.f, Pst = 1.f;
    if (PASS == 2) { for (int sg = 0; sg < seg; ++sg) { const f32x2 sv = SUM[(size_t)(b * 8 + sg) * 1024 + n * 128 + sch]; hst = sv.x * hst + sv.y; } }
    LAS f32x2* GS = (LAS f32x2*)(lds + LRU_XCB);
    unsigned xin[11];
#pragma unroll
    for (int i = 0; i < 11; ++i) { const int t = seg * 1024 + tg * 8 - 3 + i; xin[i] = (t >= 0) ? *(const unsigned*)(H0 + (tb + t) * H0W + n * 128 + ch2) : 0u; }
    for (int c = 0; c < 16; ++c) {
        const int t0 = seg * 1024 + c * 64;
        __syncthreads();
        unsigned gq[8];
        if (PASS == 2) {
#pragma unroll
            for (int i = 0; i < 8; ++i) gq[i] = *(const unsigned*)(H0 + (tb + t0 + tg * 8 + i) * H0W + 1024 + n * 128 + ch2); }
        { float xa[11][2];
#pragma unroll
          for (int i = 0; i < 11; ++i) { xa[i][0] = bflo(xin[i]); xa[i][1] = bfhi(xin[i]); }
          if (c < 15) {
#pragma unroll
              for (int i = 0; i < 11; ++i) xin[i] = *(const unsigned*)(H0 + (tb + t0 + 64 + tg * 8 - 3 + i) * H0W + n * 128 + ch2); }
#pragma unroll
          for (int i = 0; i < 8; ++i) { const int tl = tg * 8 + i;
              const float x0 = cb[0] + cw[0][0] * xa[i][0] + cw[1][0] * xa[i + 1][0] + cw[2][0] * xa[i + 2][0] + cw[3][0] * xa[i + 3][0];
              const float x1 = cb[1] + cw[0][1] * xa[i][1] + cw[1][1] * xa[i + 1][1] + cw[2][1] * xa[i + 2][1] + cw[3][1] * xa[i + 3][1];
              *(LAS f32x2*)(XCF + tl * 128 + ch2) = (f32x2){x0, x1}; *(LAS unsigned*)(XCB + tl * 136 + ch2) = pk2(x0, x1); } }
        __syncthreads();
        f32x16 ar, ai;
#pragma unroll
        for (int i = 0; i < 16; ++i) { ar[i] = 0.f; ai[i] = 0.f; }
#pragma unroll
        for (int s = 0; s < 8; ++s) { const bf16x8 af = *(const LAS bf16x8*)(XCB + (32 * tt + r) * 136 + 16 * s + 8 * hh); ar = MFMA32(af, wa[s], ar); ai = MFMA32(af, wx[s], ai); }
#pragma unroll
        for (int i = 0; i < 16; ++i) { const int tl = 32 * tt + (i & 3) + 8 * (i >> 2) + 4 * hh, cl = 32 * ct + r;
            const float rg = fsigmoid(ar[i] + ba), ig = fsigmoid(ai[i] + bx), la = rg * c8, a = __expf(la), y2 = 2.0f * la;
            float pp = 1.0f / 5040.0f; pp = pp * y2 + 1.0f / 720.0f; pp = pp * y2 + 1.0f / 120.0f; pp = pp * y2 + 1.0f / 24.0f; pp = pp * y2 + 1.0f / 6.0f; pp = pp * y2 + 0.5f; pp = pp * y2 + 1.0f;
            const float om = (y2 > -0.25f) ? (-y2 * pp) : (1.0f - __expf(y2));
            AF[tl * 128 + cl] = a; UF[tl * 128 + cl] = sqrtf(om) * ig * XCF[tl * 128 + cl]; }
        __syncthreads();
        { float Pg = 1.f, hg = 0.f;
#pragma unroll
          for (int t = 0; t < 16; ++t) { const float a = AF[(16 * sgrp + t) * 128 + sch], u = UF[(16 * sgrp + t) * 128 + sch]; hg = a * hg + u; Pg *= a; }
          GS[sgrp * 128 + sch] = (f32x2){Pg, hg}; }
        __syncthreads();
        { float hin = hst;
#pragma unroll
          for (int g = 0; g < 4; ++g) { const f32x2 gs = GS[g * 128 + sch]; if (g == sgrp) hin = hst; hst = gs.x * hst + gs.y; if (PASS == 1) Pst *= gs.x; }
          if (PASS == 2) {
#pragma unroll
              for (int t = 0; t < 16; ++t) { const int o = (16 * sgrp + t) * 128 + sch; hin = AF[o] * hin + UF[o]; UF[o] = hin; } } }
        if (PASS == 2) { __syncthreads();
#pragma unroll
            for (int i = 0; i < 8; ++i) { const int tl = tg * 8 + i; const f32x2 hv = *(const LAS f32x2*)(UF + tl * 128 + ch2); const unsigned gv = gq[i];
                *(unsigned*)(Y0 + (tb + t0 + tl) * 2048 + n * 128 + ch2) = pk2(hv.x * fsilu(bflo(gv)), hv.y * fsilu(bfhi(gv))); } }
    }
    if (PASS == 1 && tid < 128) SUM[(size_t)(b * 8 + seg) * 1024 + n * 128 + sch] = (f32x2){Pst, hst};
}

#define XB_TMO      128
#define XB_XCNT(j)  (256  + 64 * (j))
#define XB_XSUB(j)  (1280 + 64 * (j))
#define XB_XGEN(j)  (2304 + 64 * (j))
#define XB_TOP      3328
#define XB_TOPGEN   3392
#define XCD_BAR_WORDS 3456
#define XB_SPIN_CAP (1u << 18)

__device__ __forceinline__ unsigned xb_ld(unsigned* p)              { return __hip_atomic_load(p, __ATOMIC_RELAXED, __HIP_MEMORY_SCOPE_AGENT); }
__device__ __forceinline__ unsigned xb_add(unsigned* p, unsigned v) { return __hip_atomic_fetch_add(p, v, __ATOMIC_RELAXED, __HIP_MEMORY_SCOPE_AGENT); }
__device__ __forceinline__ unsigned xb_xcc_id() { return (unsigned)__builtin_amdgcn_s_getreg((3 << 11) | 20) & 0xFu; }
#define XB_SPIN(cond, bar) do { unsigned _sp = 0; while (cond) { __builtin_amdgcn_s_sleep(1); \
    if ((++_sp & 255u) == 0u) { if (xb_ld(&(bar)[XB_TMO])) break; if (_sp > XB_SPIN_CAP) { atomicAdd(&(bar)[XB_TMO], 1u); break; } } } } while (0)

struct XcdBarrier {
    unsigned* bar; unsigned x;
    volatile LAS unsigned* st;
};

__device__ __forceinline__ XcdBarrier xcd_barrier_post(unsigned* bar, volatile LAS unsigned* st) {
    XcdBarrier b; b.bar = bar; b.x = xb_xcc_id(); b.st = st;
    if (threadIdx.x == 0) (void)xb_add(&bar[XB_XCNT(b.x)], 1u);
    return b;
}
__device__ __forceinline__ void xcd_barrier_complete(unsigned* bar, unsigned x, unsigned& nloc, unsigned& nx) {
    const unsigned G = gridDim.x * gridDim.y * gridDim.z;
    unsigned sum, cnt, mine, sp = 0u;
    for (;;) {
        sum = 0u; cnt = 0u; mine = 0u;
#pragma unroll
        for (unsigned j = 0; j < 16; ++j) { const unsigned c = xb_ld(&bar[XB_XCNT(j)]); sum += c; cnt += (c > 0u) ? 1u : 0u; mine = (j == x) ? c : mine; }
        if (sum == G) break;
        __builtin_amdgcn_s_sleep(1);
        if ((++sp & 255u) == 0u) { if (xb_ld(&bar[XB_TMO])) break; if (sp > XB_SPIN_CAP) { atomicAdd(&bar[XB_TMO], 1u); break; } }
    }
    nloc = mine > 0u ? mine : 1u; nx = cnt > 0u ? cnt : 1u;
}

__device__ __forceinline__ void xcd_barrier(const XcdBarrier& b) {
    asm volatile("s_waitcnt vmcnt(0)" ::: "memory");
    __syncthreads();
    if (threadIdx.x == 0) {
        unsigned* bar = b.bar;
        __builtin_amdgcn_s_waitcnt(0);
        unsigned nloc = b.st[0], nx = b.st[1];
        if (nloc == 0u) { xcd_barrier_complete(bar, b.x, nloc, nx); b.st[0] = nloc; b.st[1] = nx; }
        const unsigned old = xb_add(&bar[XB_XSUB(b.x)], 1u);
        const unsigned gen = old / nloc;
        if (old + 1u == (gen + 1u) * nloc) {
            __builtin_amdgcn_fence(__ATOMIC_RELEASE, "agent");
            asm volatile("s_waitcnt vmcnt(0)" ::: "memory");
            const unsigned og = xb_add(&bar[XB_TOP], 1u);
            const unsigned tg = og / nx;
            if (og + 1u == (tg + 1u) * nx) xb_add(&bar[XB_TOPGEN], 1u);
            else XB_SPIN(xb_ld(&bar[XB_TOPGEN]) == tg, bar);
            __builtin_amdgcn_fence(__ATOMIC_ACQUIRE, "agent");
            xb_add(&bar[XB_XGEN(b.x)], 1u);
            asm volatile("s_waitcnt vmcnt(0)" ::: "memory");
        } else {
            XB_SPIN(xb_ld(&bar[XB_XGEN(b.x)]) == gen, bar);
            __builtin_amdgcn_fence(__ATOMIC_ACQUIRE, "agent");
            asm volatile("s_waitcnt vmcnt(0)" ::: "memory");
        }
    }
    __syncthreads();
}

constexpr int LDS_MAIN = SB_LDS > pg8::STAGE_BYTES ? SB_LDS : pg8::STAGE_BYTES;
constexpr int LDS_BYTES = LDS_MAIN + 16 + 64;
constexpr int N_PHASES = 10;
__global__ void __launch_bounds__(512) mk_fwd(Params p) {
    extern __shared__ __attribute__((aligned(16))) unsigned char lds_raw[];
    LAS unsigned char* lds = (LAS unsigned char*)lds_raw;
    const int tid = threadIdx.x, lane = tid & 63, wid = tid >> 6, G = gridDim.x, bx = blockIdx.x;
    unsigned char* ws = p.ws;
    bf16_t* W0T = (bf16_t*)(ws + WS_W0T); bf16_t* WO0T = (bf16_t*)(ws + WS_WO0T); bf16_t* W1T = (bf16_t*)(ws + WS_W1T); bf16_t* WO1T = (bf16_t*)(ws + WS_WO1T); bf16_t* WGT = (bf16_t*)(ws + WS_WGT);
    bf16_t* XB = (bf16_t*)(ws + WS_XB);  bf16_t* H0 = (bf16_t*)(ws + WS_H0);
    float* X1 = (float*)(ws + WS_H0); bf16_t* X1B = XB; bf16_t* H1 = (bf16_t*)(ws + WS_H0 + 128 * MiB);  bf16_t* Y1 = (bf16_t*)(ws + WS_H0 + 276 * MiB);
    bf16_t* Y0 = (bf16_t*)p.out;
#define IN(k) (lo <= (k) && (k) < hi)
    const int lo = p.ph_lo, hi = p.ph_hi;
    { volatile LAS unsigned* stw = (volatile LAS unsigned*)(lds + LDS_MAIN); if (tid < 4) stw[tid] = 0u; }
    __syncthreads();
    const XcdBarrier gbar = xcd_barrier_post((unsigned*)(ws + WS_BAR), (volatile LAS unsigned*)(lds + LDS_MAIN));
#define GSYNC() xcd_barrier(gbar)
#define SEAM(k) do { if (IN(k) && IN((k) + 1)) GSYNC(); } while (0)
    if (hi < 0) cg::this_grid().sync();
#define REPS(k) for (int rep_ = 0, nrep_ = (PROBE_DUP == (k) ? 2 : 1); rep_ < nrep_; ++rep_, (rep_ < nrep_ ? GSYNC() : (void)0))

    if (IN(0)) REPS(0) {
        cvt_x(p.in[0], XB, (size_t)bx * 512 + tid, (size_t)G * 512);
        LAS float* T = (LAS float*)lds;
        tr_cvt(p.in[1], 6144, 1024, 0, 4096, W0T, 0, T, bx, G);
        tr_cvt(p.in[1], 6144, 1024, 5120, 1024, W0T, 4096, T, bx, G);
        tr_cvt(p.in[1], 6144, 1024, 4096, 1024, W0T, 5120, T, bx, G);
        tr_cvt(p.in[9], 1024, 2048, 0, 1024, WO0T, 0, T, bx, G);
        tr_cvt(p.in[12], 2304, 1024, 0, 2304, W1T, 0, T, bx, G);
        tr_cvt(p.in[14], 1024, 1024, 0, 1024, WO1T, 0, T, bx, G);
        for (int n = 0; n < 8; ++n) { tr_cvt(p.in[4] + n * 16384, 128, 128, 0, 128, WGT + n * 16384, 0, T, (bx + 32 * n) % G, G); tr_cvt(p.in[6] + n * 16384, 128, 128, 0, 128, WGT + (8 + n) * 16384, 0, T, (bx + 32 * n + 16) % G, G); }
        __syncthreads();
    }
    SEAM(0);
    if (IN(1)) REPS(1) {
        { pg8::Gemm g{XB, W0T, NTOK, H0N, 1024}; pg8::StaticOrder S; S.init(NTOK, H0N, G, bx); pg8::EpiBf16<0> E{H0, H0W, nullptr, 0, 0};
          pg8::gemm_phase<pg8::EpiBf16<0>, pg8::StaticOrder>(lds, g, S, E, nullptr); }
    }
    SEAM(1);
    if (IN(2)) {
        REPS(2) { for (int item = bx; item < 256; item += G) lru_item<1>(p, lds, item); }
        REPS(12) for (int item = bx; item < 1024; item += G) sb_item(H0, Y0, lds, item >> 8, (item >> 5) & 7, item & 31);
    }
    SEAM(2);
    if (IN(3)) REPS(3) { for (int item = bx; item < 256; item += G) lru_item<2>(p, lds, item); __syncthreads(); }
    SEAM(3);
    if (IN(4)) REPS(4) { pg8::Gemm g{Y0, WO0T, NTOK, 1024, 2048}; pg8::StaticOrder S; S.init(NTOK, 1024, G, bx); pg8::EpiResF32 E{X1, 1024, p.in[0], ALPHA};
        pg8::gemm_phase<pg8::EpiResF32, pg8::StaticOrder>(lds, g, S, E, nullptr); }
    SEAM(4);
    if (PROBE_DUP == 5) { ln_phase(X1, p.out, (bf16_t*)(ws + WS_H0 + 276 * MiB), p.in[10], p.in[11], bx * 8 + wid, G * 8, lane); GSYNC(); }
    if (IN(5)) ln_phase(X1, X1, X1B, p.in[10], p.in[11], bx * 8 + wid, G * 8, lane);
    SEAM(5);
    if (IN(6)) REPS(6) {
        { pg8::Gemm g{X1B, W1T, NTOK, H1N, 1024}; pg8::StaticOrder S; S.init(NTOK, H1N, G, bx); pg8::EpiBf16<0> E{H1, H1W, nullptr, 0, 0};
          pg8::gemm_phase<pg8::EpiBf16<0>, pg8::StaticOrder>(lds, g, S, E, nullptr); }
    }
    SEAM(6);
    if (IN(7)) REPS(7) { for (int item = bx; item < 2048; item += G) { const int qt = item & 255, c = (item >> 8) & 1, b = item >> 9; swa_item(H1, p.in[13], Y1, lds, b, c, qt); } }
    SEAM(7);
    if (IN(8)) REPS(8) { pg8::Gemm g{Y1, WO1T, NTOK, 1024, 1024}; pg8::StaticOrder S; S.init(NTOK, 1024, G, bx); pg8::EpiResF32 E{p.out, 1024, X1, ALPHA};
        pg8::gemm_phase<pg8::EpiResF32, pg8::StaticOrder>(lds, g, S, E, nullptr); }
    SEAM(8);
    if (PROBE_DUP == 9) { ln_phase(p.out, (float*)(ws + WS_H0 + 128 * MiB), nullptr, p.in[15], p.in[16], bx * 8 + wid, G * 8, lane); GSYNC(); }
    if (IN(9)) ln_phase(p.out, p.out, nullptr, p.in[15], p.in[16], bx * 8 + wid, G * 8, lane);
#undef IN
#undef SEAM
}

#ifndef MK_MULTI
#define MK_MULTI 0
#endif
extern "C" void kernel_launch(void* const* d_in, const int* in_sizes, int n_in, void* d_out, int out_size, void* d_ws, size_t ws_size, hipStream_t stream) {
    static int grid = 0;
    if (grid == 0) {
        if (n_in != 17 || out_size != NTOK * DM || ws_size < WS_END) { fprintf(stderr, "kernel_launch: unexpected shapes (n_in %d, out %d, ws %zu)\n", n_in, out_size, ws_size); grid = -1; return; }
        int dev = 0, cus = 0, per_cu = 0;
        hipGetDevice(&dev); hipDeviceGetAttribute(&cus, hipDeviceAttributeMultiprocessorCount, dev);
        if (hipFuncSetAttribute((const void*)mk_fwd, hipFuncAttributeMaxDynamicSharedMemorySize, LDS_BYTES) != hipSuccess) { fprintf(stderr, "kernel_launch: hipFuncSetAttribute failed\n"); grid = -1; return; }
        hipOccupancyMaxActiveBlocksPerMultiprocessor(&per_cu, (const void*)mk_fwd, 512, LDS_BYTES);
        (void)hipGetLastError();
        if (per_cu < 1) per_cu = 1;
        grid = cus;
    }
    if (grid < 0) return;
    Params p{};
    for (int i = 0; i < 17; ++i) p.in[i] = (const float*)d_in[i];
    p.out = (float*)d_out; p.ws = (unsigned char*)d_ws;
    (void)hipMemsetAsync((unsigned char*)d_ws + WS_BAR, 0, XCD_BAR_WORDS * 4, stream);
#if MK_MULTI
    for (int ph = 0; ph < N_PHASES; ++ph) { p.ph_lo = ph; p.ph_hi = ph + 1; hipLaunchKernelGGL(mk_fwd, dim3(grid), dim3(512), LDS_BYTES, stream, p); }
#else
    p.ph_lo = 0; p.ph_hi = N_PHASES;
    void* args[] = {&p};
    hipError_t e = hipLaunchCooperativeKernel((const void*)mk_fwd, dim3(grid), dim3(512), args, LDS_BYTES, stream);
    if (e != hipSuccess) fprintf(stderr, "cooperative launch failed: %s (grid %d)\n", hipGetErrorString(e), grid);
#endif
}
```
